# Optimizing an MI355X kernel written in HIP

```python
import jax, jax.numpy as jnp
from jax import lax
import numpy as np

D_MODEL = 2048
BATCH = 4
SEQ = 2048
DEPTH = 4
DEC_BATCH = 128
DEC_SEQ = 4
PAST_LEN = 16384
PAGE_SIZE = 128

D_MIX = D_MODEL
D_CONV = D_MIX // 2
N_CONV_GROUPS = 8
CONV_GROUP = D_CONV // N_CONV_GROUPS
CONV_A_W = 3
D_DN = D_MIX - D_CONV
N_DN_HEADS = 8
DK = D_DN // N_DN_HEADS
DV = DK
CONV_B_W = 4
CHUNK = 64
D_FF = 4 * D_MODEL
EPS = 1e-6
SPLITS = [D_CONV, 2 * D_CONV, 3 * D_CONV, 3 * D_CONV + 3 * D_DN,
          3 * D_CONV + 4 * D_DN, 3 * D_CONV + 4 * D_DN + N_DN_HEADS]
D_IN = 3 * D_CONV + 4 * D_DN + 2 * N_DN_HEADS

kernel_name = "hymba_conv_gdn_hybrid_step"


def rms_norm(x, w):
    xf = x.astype(jnp.float32)
    y = xf * lax.rsqrt(jnp.mean(xf * xf, axis=-1, keepdims=True) + EPS)
    return (y * w.astype(jnp.float32)).astype(x.dtype)


def causal_dwconv(inp, buf, w):
    width = w.shape[0]
    L = inp.shape[1]
    xp = jnp.concatenate([buf.astype(inp.dtype), inp], axis=1)
    out = sum(xp[:, i:i + L] * w[i] for i in range(width))
    return out, xp[:, -(width - 1):]


def gated_delta_chunked(q, k, v, g, beta, s0):
    bsz, L, H, _ = q.shape
    C = CHUNK if L % CHUNK == 0 else L
    N = L // C

    def blk(t):
        t = t.reshape((bsz, N, C, H) + t.shape[3:])
        return jnp.moveaxis(t, 3, 1)

    qc, kc, vc, gc, bc = blk(q), blk(k), blk(v), blk(g), blk(beta)
    G = jnp.cumsum(gc, axis=-1)
    incl = jnp.tril(jnp.ones((C, C), bool))
    decay = jnp.exp(jnp.where(incl, G[..., :, None] - G[..., None, :], -jnp.inf))
    strict = jnp.tril(jnp.ones((C, C), jnp.float32), -1)
    kk = jnp.einsum('bhncd,bhnmd->bhncm', kc, kc)
    a_mat = jnp.eye(C, dtype=jnp.float32) + bc[..., :, None] * decay * kk * strict
    rhs = jnp.concatenate([bc[..., None] * vc, (bc * jnp.exp(G))[..., None] * kc], axis=-1)
    sol = lax.linalg.triangular_solve(a_mat, rhs, left_side=True, lower=True, unit_diagonal=True)
    u_base, w_mat = sol[..., :DV], sol[..., DV:]
    p_mat = jnp.einsum('bhncd,bhnmd->bhncm', qc, kc) * decay
    q_dec = qc * jnp.exp(G)[..., None]
    k_end = kc * jnp.exp(G[..., -1:] - G)[..., None]
    gam_end = jnp.exp(G[..., -1])
    xs = tuple(jnp.moveaxis(t, 2, 0) for t in (u_base, w_mat, p_mat, q_dec, k_end, gam_end))

    def step(s, xn):
        ub, wm, pm, qd, ke, ge = xn
        u = ub - jnp.einsum('bhck,bhvk->bhcv', wm, s)
        o = jnp.einsum('bhck,bhvk->bhcv', qd, s) + jnp.einsum('bhcm,bhmv->bhcv', pm, u)
        s = ge[..., None, None] * s + jnp.einsum('bhcv,bhck->bhvk', u, ke)
        return s, o

    s_fin, o = lax.scan(step, s0, xs)
    o = jnp.transpose(o, (1, 0, 3, 2, 4)).reshape(bsz, L, H, DV)
    return o, s_fin


def mixer(h, buf_a, buf_qkv, s0, w_in, conv_a_w, conv_a_norm_w, conv_qkv_w,
          a_log, dt_bias, dn_norm_w, w_out):
    bsz, L, _ = h.shape
    proj = h @ w_in
    b_a, c_a, h_a, qkv, z, a_in, b_in = jnp.split(proj, SPLITS, axis=-1)
    conv_out, new_buf_a = causal_dwconv(c_a * h_a, buf_a, conv_a_w)
    y_a = (b_a * conv_out).reshape(bsz, L, N_CONV_GROUPS, CONV_GROUP)
    y_a = rms_norm(y_a, conv_a_norm_w.reshape(N_CONV_GROUPS, CONV_GROUP)).reshape(bsz, L, D_CONV)
    qkv_c, new_buf_qkv = causal_dwconv(qkv, buf_qkv, conv_qkv_w)
    qkv_c = jax.nn.silu(qkv_c.astype(jnp.float32)).reshape(bsz, L, 3, N_DN_HEADS, DK)
    q, k, v = qkv_c[:, :, 0], qkv_c[:, :, 1], qkv_c[:, :, 2]
    q = q * lax.rsqrt(jnp.sum(q * q, -1, keepdims=True) + EPS) * (DK ** -0.5)
    k = k * lax.rsqrt(jnp.sum(k * k, -1, keepdims=True) + EPS)
    g = -jnp.exp(a_log.astype(jnp.float32)) * jax.nn.softplus(a_in.astype(jnp.float32) + dt_bias.astype(jnp.float32))
    beta = jax.nn.sigmoid(b_in.astype(jnp.float32))
    o, s_new = gated_delta_chunked(q, k, v, g, beta, s0.astype(jnp.float32))
    zf = jax.nn.silu(z.astype(jnp.float32)).reshape(bsz, L, N_DN_HEADS, DV)
    o = (rms_norm(o, dn_norm_w) * zf).reshape(bsz, L, D_DN).astype(h.dtype)
    out = jnp.concatenate([y_a, o], axis=-1) @ w_out
    return out, new_buf_a, new_buf_qkv, s_new.astype(s0.dtype)


def run_trunk(x, bufs_a, bufs_qkv, states, norm_mix_w, w_in, conv_a_w, conv_a_norm_w,
              conv_qkv_w, a_log, dt_bias, dn_norm_w, w_out, norm_ffn_w, w_up, w_down, final_norm_w):
    new_a, new_qkv, new_s = [], [], []
    for l in range(DEPTH):
        h = rms_norm(x, norm_mix_w[l])
        m, ba, bq, s = mixer(h, bufs_a[l], bufs_qkv[l], states[l], w_in[l], conv_a_w[l],
                             conv_a_norm_w[l], conv_qkv_w[l], a_log[l], dt_bias[l],
                             dn_norm_w[l], w_out[l])
        x = x + m
        h = rms_norm(x, norm_ffn_w[l])
        x = x + jnp.square(jax.nn.relu(h @ w_up[l])) @ w_down[l]
        new_a.append(ba)
        new_qkv.append(bq)
        new_s.append(s)
    return rms_norm(x, final_norm_w), jnp.stack(new_a), jnp.stack(new_qkv), jnp.stack(new_s)


def setup_inputs(seed: int = 0) -> dict:
    key = jax.random.key(seed)
    ks = jax.random.split(key, 20)
    f32 = jnp.float32
    nrm = lambda k, s, sc: jax.random.normal(k, s, f32) * sc
    dt = jnp.exp(jax.random.uniform(ks[11], (DEPTH, N_DN_HEADS), f32, np.log(1e-3), np.log(1e-1)))
    return {
        "x_prompt": nrm(ks[0], (BATCH, SEQ, D_MODEL), 1.0),
        "x_sample": nrm(ks[1], (DEC_BATCH, DEC_SEQ, D_MODEL), 1.0),
        "state_conv_a": nrm(ks[2], (DEPTH, DEC_BATCH, CONV_A_W - 1, D_CONV), 1.0),
        "state_conv_qkv": nrm(ks[3], (DEPTH, DEC_BATCH, CONV_B_W - 1, 3 * D_DN), 1.0),
        "state_delta": nrm(ks[4], (DEPTH, DEC_BATCH, N_DN_HEADS, DV, DK), 0.05),
        "norm_mix_w": 1.0 + nrm(ks[5], (DEPTH, D_MODEL), 0.02),
        "w_in": nrm(ks[6], (DEPTH, D_MODEL, D_IN), D_MODEL ** -0.5),
        "conv_a_w": nrm(ks[7], (DEPTH, CONV_A_W, D_CONV), CONV_A_W ** -0.5),
        "conv_a_norm_w": 1.0 + nrm(ks[8], (DEPTH, D_CONV), 0.02),
        "conv_qkv_w": nrm(ks[9], (DEPTH, CONV_B_W, 3 * D_DN), CONV_B_W ** -0.5),
        "a_log": jnp.log(jax.random.uniform(ks[10], (DEPTH, N_DN_HEADS), f32, 1.0, 16.0)),
        "dt_bias": dt + jnp.log(-jnp.expm1(-dt)),
        "dn_norm_w": 1.0 + nrm(ks[12], (DEPTH, DV), 0.02),
        "w_out": nrm(ks[13], (DEPTH, D_MIX, D_MODEL), D_MIX ** -0.5),
        "norm_ffn_w": 1.0 + nrm(ks[14], (DEPTH, D_MODEL), 0.02),
        "w_up": nrm(ks[15], (DEPTH, D_MODEL, D_FF), D_MODEL ** -0.5),
        "w_down": nrm(ks[16], (DEPTH, D_FF, D_MODEL), D_FF ** -0.5),
        "final_norm_w": 1.0 + nrm(ks[17], (D_MODEL,), 0.02),
    }


def reference(x_prompt, x_sample, state_conv_a, state_conv_qkv, state_delta, norm_mix_w, w_in,
              conv_a_w, conv_a_norm_w, conv_qkv_w, a_log, dt_bias, dn_norm_w, w_out,
              norm_ffn_w, w_up, w_down, final_norm_w):
    params = (norm_mix_w, w_in, conv_a_w, conv_a_norm_w, conv_qkv_w, a_log, dt_bias,
              dn_norm_w, w_out, norm_ffn_w, w_up, w_down, final_norm_w)
    zero_a = jnp.zeros((DEPTH, BATCH, CONV_A_W - 1, D_CONV), x_prompt.dtype)
    zero_qkv = jnp.zeros((DEPTH, BATCH, CONV_B_W - 1, 3 * D_DN), x_prompt.dtype)
    zero_s = jnp.zeros((DEPTH, BATCH, N_DN_HEADS, DV, DK), state_delta.dtype)
    y_prompt, new_conv_a_p, new_conv_qkv_p, new_delta_p = run_trunk(
        x_prompt, zero_a, zero_qkv, zero_s, *params)
    y_sample, new_conv_a_s, new_conv_qkv_s, new_delta_s = run_trunk(
        x_sample, state_conv_a, state_conv_qkv, state_delta, *params)
    return (y_prompt, y_sample, new_conv_a_p, new_conv_qkv_p, new_delta_p,
            new_conv_a_s, new_conv_qkv_s, new_delta_s)
```

```cpp
#ifndef HOSTSIM
#include <hip/hip_runtime.h>
#include <cstdio>
#include <cstdint>
#define DI __device__ __forceinline__
__device__ __forceinline__ int opaque_tid() { int t = threadIdx.x; asm volatile("" : "+v"(t)); return t; }
#define TID opaque_tid()
#define WAVE_OF(t) __builtin_amdgcn_readfirstlane((t) >> 6)
#define BID ((int)blockIdx.x)
#define GRID ((int)gridDim.x)
#define SYNC() __syncthreads()
#define GAS __attribute__((address_space(1)))
#define LAS __attribute__((address_space(3)))
#define WAVE_FENCE() asm volatile("s_waitcnt lgkmcnt(0)" ::: "memory")
#define EXPF(x) __expf(x)
#define LOGF(x) __logf(x)
#endif

typedef unsigned short bf16;
typedef short bf16x8 __attribute__((ext_vector_type(8)));
typedef short bf16x4 __attribute__((ext_vector_type(4)));
typedef float f32x4 __attribute__((ext_vector_type(4)));
typedef float f32x2 __attribute__((ext_vector_type(2)));
typedef unsigned u32x4 __attribute__((ext_vector_type(4)));
typedef unsigned u32x2 __attribute__((ext_vector_type(2)));

constexpr int D = 2048, DIN = 7184, NPJ = 7168, NPAD = 7424, DFF = 8192, DEPTH = 4;
constexpr int NB = 4, T = 2048, MP = NB * T, SB = 128, SL = 4, MS = SB * SL, M = MP + MS;
constexpr int H = 8, DK = 128, DV = 128, CH = 64, NCH = T / CH, DC = 1024, NG = 8, CG = 128;
constexpr float EPS = 1e-6f;
constexpr int PC_B = 0, PC_C = 1024, PC_H = 2048, PC_QKV = 3072, PC_Z = 6144;

constexpr size_t WS_CTL = 0, CTL_BYTES = 1u << 20;
constexpr size_t WL_IN = 0, WL_OUT = (size_t)NPAD * D * 2, WL_UP = WL_OUT + (size_t)D * D * 2, WL_DOWN = WL_UP + (size_t)DFF * D * 2, WL_BYTES = WL_DOWN + (size_t)D * DFF * 2;
constexpr size_t WS_W = CTL_BYTES;
constexpr size_t WS_X = WS_W + DEPTH * WL_BYTES;
constexpr size_t WS_XB = WS_X + (size_t)M * D * 4;
constexpr size_t WS_PROJ = WS_XB + (size_t)M * D * 2;
constexpr size_t WS_AB = WS_PROJ + (size_t)M * NPJ * 2;
constexpr size_t WS_MIX = WS_AB + (size_t)M * 16 * 4;
constexpr size_t WS_UP = WS_MIX + (size_t)M * D * 2;
constexpr size_t WS_MXB = WS_UP + (size_t)M * DFF * 2;
constexpr size_t CB_UBT = 0, CB_WMN = 16384, CB_QD = CB_WMN + 16384, CB_KET = CB_QD + 16384, CB_PM = CB_KET + 16384, CB_GE = CB_PM + 8192, CHB = CB_GE + 256;
constexpr size_t WS_SSQ = WS_MXB + (size_t)NB * H * NCH * CHB;
constexpr size_t SSQ_ARR = (size_t)8 * M * 8;
constexpr size_t WS_ORAW = WS_SSQ + (size_t)(2 * DEPTH + 1) * SSQ_ARR * 4;
constexpr size_t WS_PSS = WS_ORAW + (size_t)MP * DC * 2;
constexpr size_t WS_END = WS_PSS + (size_t)MP * H * 4 * 4;
static_assert(WS_END <= (size_t)1000 * 1024 * 1024, "d_ws map must stay under the guaranteed workspace");
constexpr size_t O_Y = 0, O_CA_P = (size_t)M * D, O_CQ_P = O_CA_P + (size_t)DEPTH * NB * 2 * DC, O_DL_P = O_CQ_P + (size_t)DEPTH * NB * 3 * 3072,
                 O_CA_S = O_DL_P + (size_t)DEPTH * NB * H * DV * DK, O_CQ_S = O_CA_S + (size_t)DEPTH * SB * 2 * DC, O_DL_S = O_CQ_S + (size_t)DEPTH * SB * 3 * 3072,
                 O_END = O_DL_S + (size_t)DEPTH * SB * H * DV * DK;
static_assert(O_END == 92979200ull, "output size");
constexpr int LDS_BYTES = 147456;
constexpr int NWAVES = 8;

DI unsigned f2bf(float f) { unsigned u = __builtin_bit_cast(unsigned, f); return (u + 0x7fffu + ((u >> 16) & 1u)) >> 16; }
DI float bf2f(unsigned b) { return __builtin_bit_cast(float, (b & 0xffffu) << 16); }
#ifdef HOSTSIM
DI unsigned pk2(float lo, float hi) { return f2bf(lo) | (f2bf(hi) << 16); }
DI float rsqrt_f(float x) { return 1.0f / sqrtf(x); }
DI float rcp_f(float x) { return 1.0f / x; }
#else
typedef __bf16 hwbf16x2 __attribute__((ext_vector_type(2)));
DI unsigned pk2(float lo, float hi) { const f32x2 v = {lo, hi}; const hwbf16x2 b = __builtin_convertvector(v, hwbf16x2); return __builtin_bit_cast(unsigned, b); }
DI float rsqrt_f(float x) { return __builtin_amdgcn_rsqf(x); }
DI float rcp_f(float x) { return __builtin_amdgcn_rcpf(x); }
#endif
DI unsigned bf1(float x) { return pk2(x, 0.f) & 0xffffu; }
DI float bflo(unsigned w) { return __builtin_bit_cast(float, w << 16); }
DI float bfhi(unsigned w) { return __builtin_bit_cast(float, w & 0xffff0000u); }
DI float silu_f(float x) { return x * rcp_f(1.0f + EXPF(-x)); }
DI float sigmoid_f(float x) { return rcp_f(1.0f + EXPF(-x)); }
DI float softplus_f(float x) { if (x > 20.f) return x; const float y = EXPF(x); return y < 0.03125f ? y * (1.0f - y * (0.5f - y * (0.33333334f - 0.25f * y))) : LOGF(1.0f + y); }
#ifndef HOSTSIM
DI float shfl_xor_f(float v, int m) { return __shfl_xor(v, m); }
DI float shfl_up_f(float v, int d) { return __shfl_up(v, d); }
DI f32x4 mfma16(bf16x8 a, bf16x8 b, f32x4 c) { return __builtin_amdgcn_mfma_f32_16x16x32_bf16(a, b, c, 0, 0, 0); }
DI f32x4 mfma16k(bf16x4 a, bf16x4 b, f32x4 c) { return __builtin_amdgcn_mfma_f32_16x16x16bf16_1k(a, b, c, 0, 0, 0); }
DI f32x4 mfma4(float a, float b, f32x4 c) { return __builtin_amdgcn_mfma_f32_16x16x4f32(a, b, c, 0, 0, 0); }
template <int CTRL> DI float dpp_f(float v) { return __builtin_bit_cast(float, __builtin_amdgcn_update_dpp(0, __builtin_bit_cast(int, v), CTRL, 0xF, 0xF, true)); }
DI float sum4_f(float v) { v += dpp_f<0xB1>(v); v += dpp_f<0x4E>(v); return v; }
DI float sum16_f(float v) { v = sum4_f(v); v += dpp_f<0x141>(v); v += dpp_f<0x140>(v); return v; }
#define LDS_BARRIER() do { asm volatile("s_waitcnt lgkmcnt(0)" ::: "memory"); __builtin_amdgcn_s_barrier(); asm volatile("" ::: "memory"); } while (0)
#endif
#ifndef HOSTSIM
namespace pg8 {
#define PG8_LAS __attribute__((address_space(3)))
typedef unsigned short bf16_t;
typedef short bf16x8 __attribute__((ext_vector_type(8)));
typedef float f32x4 __attribute__((ext_vector_type(4)));
typedef unsigned u32x4 __attribute__((ext_vector_type(4)));
constexpr int BM = 256, BK = 64, HALF = 128, HTB = HALF * BK * 2  , STAGE_BYTES = 8 * HTB, NXCD = 8, WGM = 8;

__host__ __device__ __forceinline__ int lds_byte(int r, int c) { const int st = (r >> 4) * 2 + (c >> 5), rr = r & 15, cc = c & 31, ob = rr * 64 + cc * 2; return st * 1024 + (ob ^ (((ob >> 9) & 1) << 5)); }
__host__ __device__ __forceinline__ void stage_rc(int b, int& R, int& C) { const int st = b / 1024, sb = b % 1024, swz = sb ^ (((sb >> 9) & 1) << 5); R = (st >> 1) * 16 + swz / 64; C = (st & 1) * 32 + (swz % 64) / 2; }
__host__ __device__ __forceinline__ int perm32(int rho) { const int n = rho >> 4, i = rho & 15; return 8 * (i >> 2) + 4 * n + (i & 3); }

struct Unit { int pm, pn; };
struct Gemm { const bf16_t* A; const bf16_t* Ax; const bf16_t* Bt; int M, N, K; };

struct StaticOrder {
    int nM, nN, nwg, G, c;
    __host__ __device__ void init(int M, int N, int G_, int c_) { nM = M / BM; nN = N / BM; nwg = nM * nN; G = G_; c = c_; }
    __host__ __device__ bool next(int i, Unit& u) const {
        const long L = (long)i * G + c; if (L >= nwg) return false;
        int wgid = (int)L; { const int q = nwg / NXCD, r = nwg % NXCD, xcd = wgid % NXCD, off = wgid / NXCD; wgid = (xcd < r ? xcd * (q + 1) : r * (q + 1) + (xcd - r) * q) + off; }
        const int nig = WGM * nN, gid = wgid / nig, fm = gid * WGM, gsz = (nM - fm) < WGM ? (nM - fm) : WGM;
        u.pm = fm + ((wgid % nig) % gsz); u.pn = (wgid % nig) / gsz; return true;
    }
    __device__ __forceinline__ void a_ready(const Unit&) const {}
    __device__ __forceinline__ void done(const Unit&) const {}
};

#define PG8_GAS __attribute__((address_space(1)))
constexpr int XROW0 = 8192, MROWS = 8704;
__device__ __forceinline__ float row_rstd(const PG8_GAS float* ssq, int row, int fq) {
    const PG8_GAS f32x4* p0 = (const PG8_GAS f32x4*)(ssq + ((size_t)(2 * fq) * MROWS + row) * 8); const PG8_GAS f32x4* p1 = (const PG8_GAS f32x4*)(ssq + ((size_t)(2 * fq + 1) * MROWS + row) * 8);
    const f32x4 a = p0[0], b = p0[1], c = p1[0], d = p1[1];
    float s = (((a[0] + a[1]) + (a[2] + a[3])) + ((b[0] + b[1]) + (b[2] + b[3]))) + (((c[0] + c[1]) + (c[2] + c[3])) + ((d[0] + d[1]) + (d[2] + d[3])));
    s += __shfl_xor(s, 16); s += __shfl_xor(s, 32);
    return 1.0f / sqrtf(s * (1.0f / 2048.0f) + 1e-6f);
}
__device__ __forceinline__ float row_rstd_main(const PG8_GAS float* ssq, int row, int fq) {
    const f32x4 a = *(const PG8_GAS f32x4*)(ssq + ((size_t)(2 * fq) * MROWS + row) * 8), c = *(const PG8_GAS f32x4*)(ssq + ((size_t)(2 * fq + 1) * MROWS + row) * 8);
    float s = ((a[0] + a[1]) + (a[2] + a[3])) + ((c[0] + c[1]) + (c[2] + c[3]));
    s += __shfl_xor(s, 16); s += __shfl_xor(s, 32);
    return 1.0f / sqrtf(s * (1.0f / 2048.0f) + 1e-6f);
}
__device__ __forceinline__ unsigned cvt_pk_bf16(float lo, float hi) { unsigned r; asm volatile("v_cvt_pk_bf16_f32 %0, %1, %2" : "=v"(r) : "v"(lo), "v"(hi)); return r; }

struct EpiProj {
    static constexpr bool PERM = true;
    PG8_GAS bf16_t* O; PG8_GAS float* AB; const PG8_GAS float* ssq;
    __device__ __forceinline__ void operator()(const f32x4 (&acc)[2][2][4][2], const Unit& u, int wr, int wc, int fr, int fq) const {
        const int row0 = u.pm * BM + wr * 64 + fr;
        float rsv[2][4];
#pragma unroll
        for (int ai = 0; ai < 2; ++ai)
#pragma unroll
            for (int m = 0; m < 4; ++m) rsv[ai][m] = (u.pm < XROW0 / BM) ? row_rstd_main(ssq, row0 + ai * HALF + m * 16, fq) : row_rstd(ssq, row0 + ai * HALF + m * 16, fq);
        if (u.pn < 28) {
            const int col0 = u.pn * BM + wc * 32 + 8 * fq;
#pragma unroll
            for (int ai = 0; ai < 2; ++ai)
#pragma unroll
                for (int m = 0; m < 4; ++m) { const int row = row0 + ai * HALF + m * 16; const float rs = rsv[ai][m]; PG8_GAS bf16_t* rowp = O + (size_t)row * 7168 + col0;
#pragma unroll
                    for (int bj = 0; bj < 2; ++bj) { const f32x4 v0 = acc[ai][bj][m][0] * rs, v1 = acc[ai][bj][m][1] * rs;
                        u32x4 w; w.x = cvt_pk_bf16(v0[0], v0[1]); w.y = cvt_pk_bf16(v0[2], v0[3]); w.z = cvt_pk_bf16(v1[0], v1[1]); w.w = cvt_pk_bf16(v1[2], v1[3]);
                        *(PG8_GAS u32x4*)(rowp + bj * HALF) = w; } }
        } else if (wc == 0) {
#pragma unroll
            for (int ai = 0; ai < 2; ++ai)
#pragma unroll
                for (int m = 0; m < 4; ++m) { const int row = row0 + ai * HALF + m * 16; const float rs = rsv[ai][m]; PG8_GAS float* rowp = AB + (size_t)row * 16 + 8 * (fq & 1);
                    if (fq < 2) { *(PG8_GAS f32x4*)(rowp) = acc[ai][0][m][0] * rs; *(PG8_GAS f32x4*)(rowp + 4) = acc[ai][0][m][1] * rs; } }
        }
    }
    __device__ __forceinline__ void extra(const f32x4 (&accx)[2], const Unit& u, int wr, int wc, int fr, int fq) const {
        const int row = XROW0 + u.pm * 16 + fr;
        if (u.pn < 28) {
            const float rs = row_rstd(ssq, row, fq); const f32x4 v0 = accx[0] * rs, v1 = accx[1] * rs;
            u32x4 w; w.x = cvt_pk_bf16(v0[0], v0[1]); w.y = cvt_pk_bf16(v0[2], v0[3]); w.z = cvt_pk_bf16(v1[0], v1[1]); w.w = cvt_pk_bf16(v1[2], v1[3]);
            *(PG8_GAS u32x4*)(O + (size_t)row * 7168 + u.pn * BM + wr * HALF + wc * 32 + 8 * fq) = w;
        } else if (wr == 0 && wc == 0) {
            const float rs = row_rstd(ssq, row, fq); PG8_GAS float* rowp = AB + (size_t)row * 16 + 8 * (fq & 1);
            if (fq < 2) { *(PG8_GAS f32x4*)(rowp) = accx[0] * rs; *(PG8_GAS f32x4*)(rowp + 4) = accx[1] * rs; }
        }
    }
};
struct EpiRes {
    static constexpr bool PERM = true;
    PG8_GAS bf16_t* XB; PG8_GAS float* ssq; int ldc; float sc; PG8_GAS float* XF;
    static __device__ __forceinline__ f32x4 lo4(const u32x4 v) { return (f32x4){__builtin_bit_cast(float, v.x << 16), __builtin_bit_cast(float, v.x & 0xffff0000u), __builtin_bit_cast(float, v.y << 16), __builtin_bit_cast(float, v.y & 0xffff0000u)}; }
    static __device__ __forceinline__ f32x4 hi4(const u32x4 v) { return (f32x4){__builtin_bit_cast(float, v.z << 16), __builtin_bit_cast(float, v.z & 0xffff0000u), __builtin_bit_cast(float, v.w << 16), __builtin_bit_cast(float, v.w & 0xffff0000u)}; }
    __device__ __forceinline__ void operator()(const f32x4 (&acc)[2][2][4][2], const Unit& u, int wr, int wc, int fr, int fq) const {
        const int row0 = u.pm * BM + wr * 64 + fr, col0 = u.pn * BM + wc * 32 + 8 * fq;
#pragma unroll
        for (int ai = 0; ai < 2; ++ai) {
            u32x4 v[4][2];
#pragma unroll
            for (int m = 0; m < 4; ++m) { const PG8_GAS bf16_t* rowb = XB + (size_t)(row0 + ai * HALF + m * 16) * ldc + col0;
#pragma unroll
                for (int bj = 0; bj < 2; ++bj) v[m][bj] = *(const PG8_GAS u32x4*)(rowb + bj * HALF); }
#pragma unroll
            for (int m = 0; m < 4; ++m) { const int row = row0 + ai * HALF + m * 16; PG8_GAS bf16_t* rowb = XB + (size_t)row * ldc + col0; float ss = 0.f;
#pragma unroll
                for (int bj = 0; bj < 2; ++bj) { const f32x4 x0 = lo4(v[m][bj]) + acc[ai][bj][m][0] * sc, x1 = hi4(v[m][bj]) + acc[ai][bj][m][1] * sc;
                    u32x4 w; w.x = cvt_pk_bf16(x0[0], x0[1]); w.y = cvt_pk_bf16(x0[2], x0[3]); w.z = cvt_pk_bf16(x1[0], x1[1]); w.w = cvt_pk_bf16(x1[2], x1[3]);
                    *(PG8_GAS u32x4*)(rowb + bj * HALF) = w;
                    if (XF) { PG8_GAS float* rowf = XF + (size_t)row * ldc + col0 + bj * HALF; *(PG8_GAS f32x4*)rowf = x0; *(PG8_GAS f32x4*)(rowf + 4) = x1; }
                    ss += ((x0[0] * x0[0] + x0[1] * x0[1]) + (x0[2] * x0[2] + x0[3] * x0[3])) + ((x1[0] * x1[0] + x1[1] * x1[1]) + (x1[2] * x1[2] + x1[3] * x1[3])); }
                ss += __shfl_xor(ss, 16); ss += __shfl_xor(ss, 32);
                if (fq == 0) ssq[((size_t)u.pn * MROWS + row) * 8 + wc] = ss; }
            asm volatile("" ::: "memory");
        }
    }
    __device__ __forceinline__ void extra(const f32x4 (&accx)[2], const Unit& u, int wr, int wc, int fr, int fq) const {
        const int row = XROW0 + u.pm * 16 + fr, col0 = u.pn * BM + wr * HALF + wc * 32 + 8 * fq;
        PG8_GAS bf16_t* rowb = XB + (size_t)row * ldc + col0;
        const u32x4 v = *(const PG8_GAS u32x4*)rowb;
        const f32x4 x0 = lo4(v) + accx[0] * sc, x1 = hi4(v) + accx[1] * sc;
        u32x4 w; w.x = cvt_pk_bf16(x0[0], x0[1]); w.y = cvt_pk_bf16(x0[2], x0[3]); w.z = cvt_pk_bf16(x1[0], x1[1]); w.w = cvt_pk_bf16(x1[2], x1[3]);
        *(PG8_GAS u32x4*)rowb = w;
        if (XF) { PG8_GAS float* rowf = XF + (size_t)row * ldc + col0; *(PG8_GAS f32x4*)rowf = x0; *(PG8_GAS f32x4*)(rowf + 4) = x1; }
        float ss = ((x0[0] * x0[0] + x0[1] * x0[1]) + (x0[2] * x0[2] + x0[3] * x0[3])) + ((x1[0] * x1[0] + x1[1] * x1[1]) + (x1[2] * x1[2] + x1[3] * x1[3]));
        ss += __shfl_xor(ss, 16); ss += __shfl_xor(ss, 32);
        if (fq == 0) ssq[((size_t)u.pn * MROWS + row) * 8 + 4 * wr + wc] = ss;
    }
};
struct EpiUp {
    static constexpr bool PERM = true;
    PG8_GAS bf16_t* O; int ldc; const PG8_GAS float* ssq;
    __device__ __forceinline__ void operator()(const f32x4 (&acc)[2][2][4][2], const Unit& u, int wr, int wc, int fr, int fq) const {
        const int row0 = u.pm * BM + wr * 64 + fr, col0 = u.pn * BM + wc * 32 + 8 * fq;
        float rsv[2][4];
#pragma unroll
        for (int ai = 0; ai < 2; ++ai)
#pragma unroll
            for (int m = 0; m < 4; ++m) rsv[ai][m] = row_rstd_main(ssq, row0 + ai * HALF + m * 16, fq);
#pragma unroll
        for (int ai = 0; ai < 2; ++ai)
#pragma unroll
            for (int m = 0; m < 4; ++m) { const int row = row0 + ai * HALF + m * 16; const float rs = rsv[ai][m]; PG8_GAS bf16_t* rowp = O + (size_t)row * ldc + col0;
#pragma unroll
                for (int bj = 0; bj < 2; ++bj) { f32x4 v0 = acc[ai][bj][m][0] * rs, v1 = acc[ai][bj][m][1] * rs;
#pragma unroll
                    for (int j = 0; j < 4; ++j) { const float a = v0[j] > 0.f ? v0[j] : 0.f, b = v1[j] > 0.f ? v1[j] : 0.f; v0[j] = a * a; v1[j] = b * b; }
                    u32x4 w; w.x = cvt_pk_bf16(v0[0], v0[1]); w.y = cvt_pk_bf16(v0[2], v0[3]); w.z = cvt_pk_bf16(v1[0], v1[1]); w.w = cvt_pk_bf16(v1[2], v1[3]);
                    *(PG8_GAS u32x4*)(rowp + bj * HALF) = w; } }
    }
    __device__ __forceinline__ void extra(const f32x4 (&accx)[2], const Unit& u, int wr, int wc, int fr, int fq) const {
        const int row = XROW0 + u.pm * 16 + fr; const float rs = row_rstd(ssq, row, fq); f32x4 v0 = accx[0] * rs, v1 = accx[1] * rs;
#pragma unroll
        for (int j = 0; j < 4; ++j) { const float a = v0[j] > 0.f ? v0[j] : 0.f, b = v1[j] > 0.f ? v1[j] : 0.f; v0[j] = a * a; v1[j] = b * b; }
        u32x4 w; w.x = cvt_pk_bf16(v0[0], v0[1]); w.y = cvt_pk_bf16(v0[2], v0[3]); w.z = cvt_pk_bf16(v1[0], v1[1]); w.w = cvt_pk_bf16(v1[2], v1[3]);
        *(PG8_GAS u32x4*)(O + (size_t)row * ldc + u.pn * BM + wr * HALF + wc * 32 + 8 * fq) = w;
    }
};
template <class Epi, class Sched, bool ALIGN_EPI = false, bool SP2 = false, bool XR = true>
__device__ __forceinline__ void gemm_phase(PG8_LAS unsigned char* lds, const Gemm g, const Sched& S, const Epi& E) {
    const int tid = opaque_tid(), wid = __builtin_amdgcn_readfirstlane(tid >> 6), lane = tid & 63, wr = wid >> 2, wc = wid & 3, fr = lane & 15, fq = lane >> 4;
    const int K = g.K, nt = K / BK;
    unsigned voffA[2], voffB[2];
#pragma unroll
    for (int i = 0; i < 2; ++i) { int R, C; stage_rc(tid * 16 + i * 8192, R, C); const int Rb = Epi::PERM ? ((R & ~31) + perm32(R & 31)) : R;
        voffA[i] = (unsigned)(R * K + C) * 2u; voffB[i] = (unsigned)(Rb * K + C) * 2u; }
    const size_t kstep = (size_t)(BK * 2);
    const size_t hstep = (size_t)HALF * K * 2;
    const size_t tstep = 2 * hstep;
    const unsigned ldsw = (unsigned)wid * 1024u;
    const unsigned ldsb = (unsigned)(size_t)lds + ldsw;
    const int aoff = lds_byte(wr * 64 + fr, fq * 8), boff = lds_byte(wc * 32 + fr, fq * 8);
#define PG8_SA(b, h) (((b) * 2 + (h)) * HTB)
#define PG8_SB(b, h) ((4 + (b) * 2 + (h)) * HTB)
#define PG8_STAGE(bufoff, gbase, voff) do { _Pragma("unroll") for (int _i = 0; _i < 2; ++_i) { unsigned _keep; \
        asm volatile("s_mov_b32 %0, m0\n\ts_mov_b32 m0, %2\n\ts_nop 0\n\tglobal_load_lds_dwordx4 %1, %3\n\ts_mov_b32 m0, %0" : "=&s"(_keep) : "v"((voff)[_i]), "s"(ldsb + (unsigned)((bufoff) + _i * 8192)), "s"(gbase) : "memory"); } } while (0)
#define PG8_LDA(dst, b, h) do { _Pragma("unroll") for (int m = 0; m < 4; ++m) _Pragma("unroll") for (int k = 0; k < 2; ++k) dst[m][k] = *(const PG8_LAS bf16x8*)(lds + PG8_SA(b, h) + aoff + m * 2048 + k * 1024); } while (0)
#define PG8_LDB(dst, b, h) do { _Pragma("unroll") for (int n = 0; n < 2; ++n) _Pragma("unroll") for (int k = 0; k < 2; ++k) dst[n][k] = *(const PG8_LAS bf16x8*)(lds + PG8_SB(b, h) + boff + n * 2048 + k * 1024); } while (0)
#define PG8_MMA(ai, bj, At, Bt) do { __builtin_amdgcn_s_setprio(1); _Pragma("unroll") for (int m = 0; m < 4; ++m) _Pragma("unroll") for (int n = 0; n < 2; ++n) _Pragma("unroll") for (int k = 0; k < 2; ++k) \
        acc[ai][bj][m][n] = __builtin_amdgcn_mfma_f32_16x16x32_bf16(Bt[n][k], At[m][k], acc[ai][bj][m][n], 0, 0, 0); __builtin_amdgcn_s_setprio(0); } while (0)
#define PG8_WAIT_V(n) asm volatile("s_waitcnt vmcnt(" #n ")" ::: "memory")
#define PG8_WAIT_L(n) asm volatile("s_waitcnt lgkmcnt(" #n ")" ::: "memory")
#define PG8_BAR __builtin_amdgcn_s_barrier()
#define PG8_SCHED __builtin_amdgcn_sched_barrier(0)
    Unit cur, nxt; int ui = 0;
    if (!S.next(0, cur)) return;
    f32x4 acc[2][2][4][2];
#pragma unroll
    for (int a = 0; a < 2; ++a)
#pragma unroll
        for (int b = 0; b < 2; ++b)
#pragma unroll
            for (int m = 0; m < 4; ++m)
#pragma unroll
                for (int n = 0; n < 2; ++n) acc[a][b][m][n] = (f32x4){0.f, 0.f, 0.f, 0.f};
    bf16x8 At[4][2], B0[2][2], B1[2][2];
    const char* cA = (const char*)g.A + (size_t)cur.pm * tstep; const char* cB = (const char*)g.Bt + (size_t)cur.pn * tstep;
    S.a_ready(cur);
    const unsigned voffX = (unsigned)(fr * K + fq * 8) * 2u;
    const size_t xstep = (size_t)16 * K * 2;
    const char* xA = (const char*)g.Ax + (size_t)cur.pm * xstep + (wid & 1) * 64;
    const unsigned xring = (unsigned)(size_t)lds + STAGE_BYTES + (wid & 1) * 1024;
    const int xoff = STAGE_BYTES + lane * 16;
    f32x4 accx[2] = {(f32x4){0.f, 0.f, 0.f, 0.f}, (f32x4){0.f, 0.f, 0.f, 0.f}}; bf16x8 Xf[2];
#define PG8_STAGEX(slot, base) do { if (XR && wid < 2) { unsigned _keep; asm volatile("s_mov_b32 %0, m0\n\ts_mov_b32 m0, %2\n\ts_nop 0\n\tglobal_load_lds_dwordx4 %1, %3\n\ts_mov_b32 m0, %0" : "=&s"(_keep) : "v"(voffX), "s"(xring + (unsigned)(slot) * 2048u), "s"(base) : "memory"); } } while (0)
#define PG8_LDX(slot) do { if constexpr (XR) { Xf[0] = *(const PG8_LAS bf16x8*)(lds + xoff + (slot) * 2048); Xf[1] = *(const PG8_LAS bf16x8*)(lds + xoff + (slot) * 2048 + 1024); } } while (0)
#define PG8_WAIT_V89() do { if (XR && wid < 2) PG8_WAIT_V(9); else PG8_WAIT_V(8); } while (0)
#define PG8_MMAX() do { if constexpr (XR) { if (wr == 0) { accx[0] = __builtin_amdgcn_mfma_f32_16x16x32_bf16(B0[0][0], Xf[0], accx[0], 0, 0, 0); accx[1] = __builtin_amdgcn_mfma_f32_16x16x32_bf16(B0[1][0], Xf[0], accx[1], 0, 0, 0); \
                                       accx[0] = __builtin_amdgcn_mfma_f32_16x16x32_bf16(B0[0][1], Xf[1], accx[0], 0, 0, 0); accx[1] = __builtin_amdgcn_mfma_f32_16x16x32_bf16(B0[1][1], Xf[1], accx[1], 0, 0, 0); } \
                         else         { accx[0] = __builtin_amdgcn_mfma_f32_16x16x32_bf16(B1[0][0], Xf[0], accx[0], 0, 0, 0); accx[1] = __builtin_amdgcn_mfma_f32_16x16x32_bf16(B1[1][0], Xf[0], accx[1], 0, 0, 0); \
                                       accx[0] = __builtin_amdgcn_mfma_f32_16x16x32_bf16(B1[0][1], Xf[1], accx[0], 0, 0, 0); accx[1] = __builtin_amdgcn_mfma_f32_16x16x32_bf16(B1[1][1], Xf[1], accx[1], 0, 0, 0); } } } while (0)
    PG8_STAGEX(0, xA); PG8_STAGEX(1, xA + kstep);
    {
        PG8_STAGE(PG8_SB(0, 0), cB, voffB); PG8_STAGE(PG8_SB(0, 1), cB + hstep, voffB); PG8_STAGE(PG8_SA(0, 0), cA, voffA); PG8_STAGE(PG8_SA(0, 1), cA + hstep, voffA);
        if (wr == 1) PG8_BAR;
        PG8_WAIT_V(2); PG8_BAR;
        PG8_STAGE(PG8_SB(1, 0), cB + kstep, voffB); PG8_STAGE(PG8_SA(1, 0), cA + kstep, voffA); PG8_STAGE(PG8_SB(1, 1), cB + hstep + kstep, voffB);
        PG8_WAIT_V(6); PG8_BAR;
    }
    for (;;) {
        const bool has_next = S.next(ui + 1, nxt);
        const char* nA = has_next ? (const char*)g.A + (size_t)nxt.pm * tstep : cA; const char* nB = has_next ? (const char*)g.Bt + (size_t)nxt.pn * tstep : cB;
        const char* nxA = has_next ? (const char*)g.Ax + (size_t)nxt.pm * xstep + (wid & 1) * 64 : xA;
        for (int t = 0; t < nt; t += 2) {
            const bool last = (t == nt - 2);
            const char* a1 = cA + (size_t)(t + 1) * kstep;
            const char* a2 = last ? nA : cA + (size_t)(t + 2) * kstep; const char* b2 = last ? nB : cB + (size_t)(t + 2) * kstep;
            const char* a3 = a2 + kstep; const char* b3 = b2 + kstep;
            if (last && has_next) S.a_ready(nxt);
            const char* x2 = last ? nxA : xA + (size_t)(t + 2) * kstep;
            const int s0 = t & 2;
            PG8_LDB(B0, 0, 0); PG8_LDB(B1, 0, 1); PG8_SCHED; PG8_LDA(At, 0, 0); PG8_LDX(s0); PG8_STAGE(PG8_SA(1, 1), a1 + hstep, voffA); PG8_STAGEX(s0 ^ 2, x2);
            PG8_WAIT_V89(); PG8_WAIT_L(0); PG8_BAR; PG8_MMA(0, 0, At, B0); PG8_MMA(0, 1, At, B1); PG8_MMAX(); PG8_BAR; PG8_SCHED;
            PG8_LDA(At, 0, 1); PG8_STAGE(PG8_SB(0, 0), b2, voffB); PG8_STAGE(PG8_SB(0, 1), b2 + hstep, voffB); PG8_STAGE(PG8_SA(0, 0), a2, voffA);
            PG8_WAIT_V89(); PG8_WAIT_L(0); PG8_BAR; PG8_MMA(1, 0, At, B0); PG8_MMA(1, 1, At, B1); PG8_BAR; PG8_SCHED;
            PG8_LDB(B0, 1, 0); PG8_LDB(B1, 1, 1); PG8_SCHED; PG8_LDA(At, 1, 0); PG8_LDX(s0 + 1); PG8_STAGE(PG8_SA(0, 1), a2 + hstep, voffA); PG8_STAGEX((s0 ^ 2) + 1, x2 + kstep);
            PG8_WAIT_V89(); PG8_WAIT_L(0); PG8_BAR; PG8_MMA(0, 0, At, B0); PG8_MMA(0, 1, At, B1); PG8_MMAX(); PG8_BAR; PG8_SCHED;
            PG8_LDA(At, 1, 1); PG8_STAGE(PG8_SB(1, 0), b3, voffB); PG8_STAGE(PG8_SB(1, 1), b3 + hstep, voffB); PG8_STAGE(PG8_SA(1, 0), a3, voffA);
            PG8_WAIT_V89(); PG8_WAIT_L(0); PG8_BAR; PG8_MMA(1, 0, At, B0); PG8_MMA(1, 1, At, B1); PG8_BAR; PG8_SCHED;
        }
        if constexpr (ALIGN_EPI) { if (wr == 0) PG8_BAR; }
        { int fr_ = fr, fq_ = fq; asm volatile("" : "+v"(fr_), "+v"(fq_));
          E(acc, cur, wr, wc, fr_, fq_); if constexpr (XR) E.extra(accx, cur, wr, wc, fr_, fq_); S.done(cur); }
        if (!has_next) break;
#pragma unroll
        for (int a = 0; a < 2; ++a)
#pragma unroll
            for (int b = 0; b < 2; ++b)
#pragma unroll
                for (int m = 0; m < 4; ++m)
#pragma unroll
                    for (int n = 0; n < 2; ++n) acc[a][b][m][n] = (f32x4){0.f, 0.f, 0.f, 0.f};
        accx[0] = (f32x4){0.f, 0.f, 0.f, 0.f}; accx[1] = accx[0];
        cur = nxt; cA = nA; cB = nB; xA = nxA; ++ui;
        if constexpr (ALIGN_EPI) { if (wr == 1) PG8_BAR; }
    }
    PG8_WAIT_V(0);
    if constexpr (!ALIGN_EPI) { if (wr == 0) PG8_BAR; }
    PG8_BAR;
#undef PG8_SA
#undef PG8_SB
#undef PG8_STAGE
#undef PG8_LDA
#undef PG8_LDB
#undef PG8_MMA
#undef PG8_WAIT_V
#undef PG8_WAIT_L
#undef PG8_BAR
#undef PG8_SCHED
#undef PG8_STAGEX
#undef PG8_LDX
#undef PG8_WAIT_V89
#undef PG8_MMAX
}
}
#define XB_TMO      128
#define XB_XCNT(j)  (256  + 64 * (j))
#define XB_XSUB(j)  (1280 + 64 * (j))
#define XB_XGEN(j)  (2304 + 64 * (j))
#define XB_TOP      3328
#define XB_TOPGEN   3392
#define XCD_BAR_WORDS 3456
#define XB_SPIN_CAP (1u << 18)

__device__ __forceinline__ unsigned xb_ld(unsigned* p)              { return __hip_atomic_load(p, __ATOMIC_RELAXED, __HIP_MEMORY_SCOPE_AGENT); }
__device__ __forceinline__ unsigned xb_add(unsigned* p, unsigned v) { return __hip_atomic_fetch_add(p, v, __ATOMIC_RELAXED, __HIP_MEMORY_SCOPE_AGENT); }
__device__ __forceinline__ unsigned xb_xcc_id() { return (unsigned)__builtin_amdgcn_s_getreg((3 << 11) | 20) & 0xFu; }
#define XB_SPIN(cond, bar) do { unsigned _sp = 0; while (cond) { __builtin_amdgcn_s_sleep(1); \
    if ((++_sp & 255u) == 0u) { if (xb_ld(&(bar)[XB_TMO])) break; if (_sp > XB_SPIN_CAP) { atomicAdd(&(bar)[XB_TMO], 1u); break; } } } } while (0)

struct XcdBarrier {
    unsigned* bar; unsigned x;
    volatile LAS unsigned* st;
};

__device__ __forceinline__ XcdBarrier xcd_barrier_post(unsigned* bar, volatile LAS unsigned* st) {
    XcdBarrier b; b.bar = bar; b.x = xb_xcc_id(); b.st = st;
    if (threadIdx.x == 0) (void)xb_add(&bar[XB_XCNT(b.x)], 1u);
    return b;
}
__device__ __forceinline__ void xcd_barrier_complete(unsigned* bar, unsigned x, unsigned& nloc, unsigned& nx) {
    const unsigned G = gridDim.x * gridDim.y * gridDim.z;
    unsigned sum, cnt, mine, sp = 0u;
    for (;;) {
        sum = 0u; cnt = 0u; mine = 0u;
#pragma unroll
        for (unsigned j = 0; j < 16; ++j) { const unsigned c = xb_ld(&bar[XB_XCNT(j)]); sum += c; cnt += (c > 0u) ? 1u : 0u; mine = (j == x) ? c : mine; }
        if (sum == G) break;
        __builtin_amdgcn_s_sleep(1);
        if ((++sp & 255u) == 0u) { if (xb_ld(&bar[XB_TMO])) break; if (sp > XB_SPIN_CAP) { atomicAdd(&bar[XB_TMO], 1u); break; } }
    }
    nloc = mine > 0u ? mine : 1u; nx = cnt > 0u ? cnt : 1u;
}

__device__ __forceinline__ void xcd_barrier(const XcdBarrier& b) {
    asm volatile("s_waitcnt vmcnt(0)" ::: "memory");
    __syncthreads();
    if (threadIdx.x == 0) {
        unsigned* bar = b.bar;
        __builtin_amdgcn_s_waitcnt(0);
        unsigned nloc = b.st[0], nx = b.st[1];
        if (nloc == 0u) { xcd_barrier_complete(bar, b.x, nloc, nx); b.st[0] = nloc; b.st[1] = nx; }
        const unsigned old = xb_add(&bar[XB_XSUB(b.x)], 1u);
        const unsigned gen = old / nloc;
        if (old + 1u == (gen + 1u) * nloc) {
            __builtin_amdgcn_fence(__ATOMIC_RELEASE, "agent");
            asm volatile("s_waitcnt vmcnt(0)" ::: "memory");
            const unsigned og = xb_add(&bar[XB_TOP], 1u);
            const unsigned tg = og / nx;
            if (og + 1u == (tg + 1u) * nx) xb_add(&bar[XB_TOPGEN], 1u);
            else XB_SPIN(xb_ld(&bar[XB_TOPGEN]) == tg, bar);
            __builtin_amdgcn_fence(__ATOMIC_ACQUIRE, "agent");
            xb_add(&bar[XB_XGEN(b.x)], 1u);
            asm volatile("s_waitcnt vmcnt(0)" ::: "memory");
        } else {
            XB_SPIN(xb_ld(&bar[XB_XGEN(b.x)]) == gen, bar);
            __builtin_amdgcn_fence(__ATOMIC_ACQUIRE, "agent");
            asm volatile("s_waitcnt vmcnt(0)" ::: "memory");
        }
    }
    __syncthreads();
}
#endif
typedef GAS float gf32; typedef GAS bf16 gbf16; typedef GAS unsigned char gu8; typedef GAS f32x4 gf32x4; typedef GAS u32x4 gu32x4; typedef GAS u32x2 gu32x2;
typedef LAS float lf32; typedef LAS bf16 lbf16; typedef LAS unsigned char lu8; typedef LAS f32x4 lf32x4; typedef LAS u32x4 lu32x4; typedef LAS u32x2 lu32x2; typedef LAS bf16x8 lbf16x8;
struct P {
    const gf32 *x_prompt, *x_sample, *st_conv_a, *st_conv_qkv, *st_delta, *norm_mix_w, *w_in, *conv_a_w, *conv_a_norm_w, *conv_qkv_w, *a_log, *dt_bias, *dn_norm_w, *w_out, *norm_ffn_w, *w_up, *w_down, *final_norm_w;
    gf32* out; gu8* ws;
    gf32* X; gbf16* XB; gf32* SSQ; gbf16* PROJ; gf32* AB; gbf16* MIX; gbf16* UP; gu8* MXB; gbf16* ORAW; gf32* PSS;
};
DI float wave_sum(float v) {
#pragma unroll
    for (int o = 1; o < 64; o <<= 1) v += shfl_xor_f(v, o);
    return v;
}
DI bf16x8 frag2(const lbf16* base, int off0, int off1) {
    const u32x2 lo = *(const lu32x2*)(base + off0), hi = *(const lu32x2*)(base + off1);
    u32x4 w; w.x = lo.x; w.y = lo.y; w.z = hi.x; w.w = hi.y; return __builtin_bit_cast(bf16x8, w);
}
DI bf16x8 pack8(const f32x4& a, const f32x4& b) { u32x4 w; w.x = pk2(a[0], a[1]); w.y = pk2(a[2], a[3]); w.z = pk2(b[0], b[1]); w.w = pk2(b[2], b[3]); return __builtin_bit_cast(bf16x8, w); }

constexpr int TS = 65;
DI void transpose64(const gf32* W, int ldw, int ncv, int K, gbf16* WT, const gf32* scale, lf32* scr, int kb, int nb, int lane) {
    const int k0 = 64 * kb, n0 = 64 * nb, kr = lane >> 4, n4 = 4 * (lane & 15); const bool ok = (n0 + n4) < ncv;
    f32x4 v[16];
#pragma unroll
    for (int i = 0; i < 16; ++i) v[i] = ok ? *(const gf32x4*)(W + (size_t)(k0 + 4 * i + kr) * ldw + n0 + n4) : (f32x4){0.f, 0.f, 0.f, 0.f};
#pragma unroll
    for (int i = 0; i < 16; ++i) { const int k = 4 * i + kr; const float s = scale ? scale[k0 + k] : 1.0f;
        scr[k * TS + n4] = v[i][0] * s; scr[k * TS + n4 + 1] = v[i][1] * s; scr[k * TS + n4 + 2] = v[i][2] * s; scr[k * TS + n4 + 3] = v[i][3] * s; }
    WAVE_FENCE();
    const int kc = lane & 7;
#pragma unroll
    for (int j = 0; j < 8; ++j) { const int n = (lane >> 3) + 8 * j; const lf32* s = scr + (8 * kc) * TS + n;
        u32x4 o; o.x = pk2(s[0], s[TS]); o.y = pk2(s[2 * TS], s[3 * TS]); o.z = pk2(s[4 * TS], s[5 * TS]); o.w = pk2(s[6 * TS], s[7 * TS]);
        if (n0 + n < ncv) *(gu32x4*)(WT + (size_t)(n0 + n) * K + k0 + 8 * kc) = o; }
    WAVE_FENCE();
}
#ifdef NO_OVERLAP_CONV
constexpr bool CONV_IN_MX2 = false;
#else
constexpr bool CONV_IN_MX2 = true;
#endif
constexpr int IT_IN = 32 * 113, IT_OUT = 32 * 32, IT_UP = 32 * 128, IT_DOWN = 128 * 32, IT_LAYER = IT_IN + IT_OUT + IT_UP + IT_DOWN;
constexpr int CONV_SPLIT = 8800;
DI void convert_layer(const P& p, int l, lu8* lds, int wi, int nw, int wave, int lane, int it0 = 0, int it1 = IT_LAYER) {
    lf32* scr = (lf32*)(lds + wave * 16640);
    gu8* wl = p.ws + WS_W + (size_t)l * WL_BYTES;
    for (int it = it0 + wi; it < it1; it += nw) {
        int r = it;
        if (r < IT_IN) { transpose64(p.w_in + (size_t)l * D * DIN, DIN, DIN, D, (gbf16*)(wl + WL_IN), p.norm_mix_w + l * D, scr, r / 113, r % 113, lane); continue; } r -= IT_IN;
        if (r < IT_OUT) { transpose64(p.w_out + (size_t)l * D * D, D, D, D, (gbf16*)(wl + WL_OUT), nullptr, scr, r / 32, r % 32, lane); continue; } r -= IT_OUT;
        if (r < IT_UP) { transpose64(p.w_up + (size_t)l * D * DFF, DFF, DFF, D, (gbf16*)(wl + WL_UP), p.norm_ffn_w + l * D, scr, r / 128, r % 128, lane); continue; } r -= IT_UP;
        transpose64(p.w_down + (size_t)l * DFF * D, D, D, DFF, (gbf16*)(wl + WL_DOWN), nullptr, scr, r / 32, r % 32, lane);
    }
}
DI void p0_prologue(const P& p, lu8* lds) {
    const int tid = TID, lane = tid & 63, wave = WAVE_OF(tid), gw = BID * NWAVES + wave, ngw = GRID * NWAVES;
#ifdef NO_OVERLAP_CONV
    for (int l = 0; l < DEPTH; ++l) convert_layer(p, l, lds, gw, ngw, wave, lane);
#else
    convert_layer(p, 0, lds, gw, ngw, wave, lane);
#endif
    for (int m = gw; m < M; m += ngw) {
        const gf32x4* xr = (const gf32x4*)(m < MP ? p.x_prompt + (size_t)m * D : p.x_sample + (size_t)(m - MP) * D) + lane; f32x4 v[8]; float s = 0.f;
#pragma unroll
        for (int j = 0; j < 8; ++j) { v[j] = xr[64 * j]; s += (v[j][0] * v[j][0] + v[j][1] * v[j][1]) + (v[j][2] * v[j][2] + v[j][3] * v[j][3]); }
        s = wave_sum(s);
        gu32x2* o = (gu32x2*)(p.XB + (size_t)m * D) + lane;
#pragma unroll
        for (int j = 0; j < 8; ++j) { u32x2 w; w.x = pk2(v[j][0], v[j][1]); w.y = pk2(v[j][2], v[j][3]); o[64 * j] = w; }
        if (lane < 16) *(gf32x4*)(p.SSQ + ((size_t)(lane >> 1) * M + m) * 8 + (lane & 1) * 4) = (f32x4){lane == 0 ? s : 0.f, 0.f, 0.f, 0.f};
    }
}
DI void fin_phase(const P& p) {
    const int tid = TID, lane = tid & 63, gw = BID * NWAVES + WAVE_OF(tid), ngw = GRID * NWAVES;
    f32x4 g[8];
#pragma unroll
    for (int j = 0; j < 8; ++j) g[j] = ((const gf32x4*)p.final_norm_w)[64 * j + lane];
    for (int m = gw; m < M; m += ngw) {
        const gu32x2* xr = (const gu32x2*)(p.XB + (size_t)m * D) + lane; float s = 0.f;
        u32x2 xv[8];
#pragma unroll
        for (int j = 0; j < 8; ++j) xv[j] = xr[64 * j];
#pragma unroll
        for (int t = 0; t < 8; ++t) { const gf32x4* q = (const gf32x4*)(p.SSQ + (size_t)(2 * DEPTH) * SSQ_ARR + ((size_t)t * M + m) * 8); const f32x4 a = q[0]; s += (a[0] + a[1]) + (a[2] + a[3]); if (m >= MP) { const f32x4 c = q[1]; s += (c[0] + c[1]) + (c[2] + c[3]); } }
        const float r = rsqrt_f(s * (1.0f / D) + EPS);
        gf32x4* o = (gf32x4*)(p.out + O_Y + (size_t)m * D) + lane;
#pragma unroll
        for (int j = 0; j < 8; ++j) o[64 * j] = (f32x4){bflo(xv[j].x), bfhi(xv[j].x), bflo(xv[j].y), bfhi(xv[j].y)} * r * g[j];
    }
}

template <int NT>
DI void mx1_conva_item(const P& p, int l, int m0, int half, int lane, bool smp, int sb, bool first, gf32* dst) {
    const gf32* cw = p.conv_a_w + (size_t)l * 3 * DC; const gf32* nw = p.conv_a_norm_w + (size_t)l * DC;
    const int ch = 512 * half + 8 * lane;
    u32x4 cc[NT], hh[NT], bb[NT];
#pragma unroll
    for (int i = 0; i < NT; ++i) { const gbf16* r = p.PROJ + (size_t)(m0 + i) * NPJ + ch; cc[i] = *(const gu32x4*)(r + PC_C); hh[i] = *(const gu32x4*)(r + PC_H); bb[i] = *(const gu32x4*)(r + PC_B); }
    float w0[8], w1[8], w2[8], gn[8], u2[8], u1[8];
    if (smp) {
        const gf32* s0 = p.st_conv_a + ((size_t)(l * SB + sb) * 2) * DC + ch;
#pragma unroll
        for (int q = 0; q < 2; ++q) { const f32x4 a = *(const gf32x4*)(s0 + 4 * q), bq = *(const gf32x4*)(s0 + DC + 4 * q);
#pragma unroll
            for (int e = 0; e < 4; ++e) { u2[4 * q + e] = a[e]; u1[4 * q + e] = bq[e]; } }
    } else if (first) {
#pragma unroll
        for (int e = 0; e < 8; ++e) { u2[e] = 0.f; u1[e] = 0.f; }
    } else {
        const u32x4 c2 = *(const gu32x4*)(p.PROJ + (size_t)(m0 - 2) * NPJ + PC_C + ch), h2 = *(const gu32x4*)(p.PROJ + (size_t)(m0 - 2) * NPJ + PC_H + ch);
        const u32x4 c1 = *(const gu32x4*)(p.PROJ + (size_t)(m0 - 1) * NPJ + PC_C + ch), h1 = *(const gu32x4*)(p.PROJ + (size_t)(m0 - 1) * NPJ + PC_H + ch);
#pragma unroll
        for (int e = 0; e < 4; ++e) { u2[2 * e] = bflo(c2[e]) * bflo(h2[e]); u2[2 * e + 1] = bfhi(c2[e]) * bfhi(h2[e]); u1[2 * e] = bflo(c1[e]) * bflo(h1[e]); u1[2 * e + 1] = bfhi(c1[e]) * bfhi(h1[e]); }
    }
#pragma unroll
    for (int q = 0; q < 2; ++q) { const f32x4 a = *(const gf32x4*)(cw + ch + 4 * q), bq = *(const gf32x4*)(cw + DC + ch + 4 * q), c = *(const gf32x4*)(cw + 2 * DC + ch + 4 * q), d = *(const gf32x4*)(nw + ch + 4 * q);
#pragma unroll
        for (int e = 0; e < 4; ++e) { w0[4 * q + e] = a[e]; w1[4 * q + e] = bq[e]; w2[4 * q + e] = c[e]; gn[4 * q + e] = d[e]; } }
#pragma unroll
    for (int i = 0; i < NT; ++i) {
        float u0[8], y[8]; float ss = 0.f;
#pragma unroll
        for (int e = 0; e < 4; ++e) { u0[2 * e] = bflo(cc[i][e]) * bflo(hh[i][e]); u0[2 * e + 1] = bfhi(cc[i][e]) * bfhi(hh[i][e]); }
#pragma unroll
        for (int e = 0; e < 8; ++e) { const float bv = (e & 1) ? bfhi(bb[i][e >> 1]) : bflo(bb[i][e >> 1]); y[e] = bv * (w0[e] * u2[e] + w1[e] * u1[e] + w2[e] * u0[e]); ss += y[e] * y[e]; }
        ss = sum16_f(ss);
        const float rs = rsqrt_f(ss * (1.0f / CG) + EPS);
        u32x4 o;
#pragma unroll
        for (int e = 0; e < 4; ++e) o[e] = pk2(y[2 * e] * rs * gn[2 * e], y[2 * e + 1] * rs * gn[2 * e + 1]);
        *(gu32x4*)(p.MIX + (size_t)(m0 + i) * D + ch) = o;
#pragma unroll
        for (int e = 0; e < 8; ++e) { u2[e] = u1[e]; u1[e] = u0[e]; }
    }
    if (dst) {
        *(gf32x4*)(dst + ch) = (f32x4){u2[0], u2[1], u2[2], u2[3]}; *(gf32x4*)(dst + ch + 4) = (f32x4){u2[4], u2[5], u2[6], u2[7]};
        *(gf32x4*)(dst + DC + ch) = (f32x4){u1[0], u1[1], u1[2], u1[3]}; *(gf32x4*)(dst + DC + ch + 4) = (f32x4){u1[4], u1[5], u1[6], u1[7]};
    }
}
DI void mx1_conva_phase(const P& p, int l) {
    const int tid = TID, lane = tid & 63, wave = WAVE_OF(tid), gw = BID * NWAVES + wave, ngw = GRID * NWAVES;
    for (int wi = gw; wi < 2 * 1024; wi += ngw) { const int blk = wi >> 1, b = blk >> 8, t0 = (blk & 255) * 8;
        mx1_conva_item<8>(p, l, b * T + t0, wi & 1, lane, false, 0, t0 == 0, (t0 + 8 == T) ? p.out + O_CA_P + ((size_t)(l * NB + b) * 2) * DC : (gf32*)nullptr); }
    for (int si = BID + GRID * wave; si < 2 * SB; si += ngw) { const int sb = si >> 1;
        mx1_conva_item<4>(p, l, MP + 4 * sb, si & 1, lane, true, sb, false, p.out + O_CA_S + ((size_t)(l * SB + sb) * 2) * DC); }
}
DI void mx1_convstate_copy(const P& p, int l) {
    const int gtid = BID * (NWAVES * 64) + TID, nthr = GRID * NWAVES * 64;
    constexpr int NPQ = NB * 3 * 3072, NSQ = SB * 3 * 3072;
    for (int i = gtid; i < NPQ + NSQ; i += nthr) {
        if (i < NPQ) { const int b = i / 9216, r = i % 9216, ii = r / 3072, j = r % 3072;
            p.out[O_CQ_P + (size_t)l * NPQ + i] = bf2f(p.PROJ[(size_t)(b * T + T - 3 + ii) * NPJ + PC_QKV + j]); }
        else { const int k = i - NPQ, sb = k / 9216, r = k % 9216, ii = r / 3072, j = r % 3072;
            p.out[O_CQ_S + (size_t)l * NSQ + k] = bf2f(p.PROJ[(size_t)(MP + 4 * sb + 1 + ii) * NPJ + PC_QKV + j]); }
    }
}
constexpr int L1_AM = 0, L1_KF = 17408, L1_VF = 51200, L1_KB = 84992, L1_QB = 102400, L1_SM = 119808;
constexpr int FS = 132, BS = 136, AS = 68;
DI void mx1_chunk_item(const P& p, int l, int it, int itn, lu8* lds) {
    const int tid = TID, lane = tid & 63, w = WAVE_OF(tid);
    const int b = it >> 8, h = (it >> 5) & 7, n = it & 31;
    const int row0 = b * T + n * CH;
    lf32* AM = (lf32*)(lds + L1_AM); lf32* KF = (lf32*)(lds + L1_KF); lf32* VF = (lf32*)(lds + L1_VF);
    lbf16* KB = (lbf16*)(lds + L1_KB); lbf16* QB = (lbf16*)(lds + L1_QB); lf32* SM = (lf32*)(lds + L1_SM);
    lf32* sG = SM, *sBeta = SM + 64, *sEG = SM + 128, *sEGE = SM + 192;
    lbf16* WST = KB;
    gu8* rec = p.MXB + (size_t)it * CHB;
    const gf32* cw = p.conv_qkv_w + (size_t)l * 4 * 3072;
    u32x4 rr[2][3][4];
#pragma unroll
    for (int i = 0; i < 2; ++i) {
        const int idx = tid + 512 * i, c = idx >> 4, d0 = 8 * (idx & 15);
        const bool z3 = (n == 0 && c < 3), z2 = (n == 0 && c < 2), z1 = (n == 0 && c < 1);
#pragma unroll
        for (int which = 0; which < 3; ++which) {
            const gbf16* src = p.PROJ + (size_t)(row0 + c) * NPJ + PC_QKV + which * 1024 + h * 128 + d0;
            rr[i][which][0] = *(const gu32x4*)src;
            rr[i][which][1] = z1 ? (u32x4){0u, 0u, 0u, 0u} : *(const gu32x4*)(src - (ptrdiff_t)NPJ);
            rr[i][which][2] = z2 ? (u32x4){0u, 0u, 0u, 0u} : *(const gu32x4*)(src - (ptrdiff_t)2 * NPJ);
            rr[i][which][3] = z3 ? (u32x4){0u, 0u, 0u, 0u} : *(const gu32x4*)(src - (ptrdiff_t)3 * NPJ);
        }
    }
    if (tid < 64) {
        const float a = p.AB[(size_t)(row0 + tid) * 16 + h], bb = p.AB[(size_t)(row0 + tid) * 16 + 8 + h];
        float G = -EXPF(p.a_log[l * H + h]) * softplus_f(a + p.dt_bias[l * H + h]);
#pragma unroll
        for (int off = 1; off < 64; off <<= 1) { const float t = shfl_up_f(G, off); if (lane >= off) G += t; }
        sG[tid] = G; sBeta[tid] = sigmoid_f(bb); sEG[tid] = EXPF(G);
    }
    SYNC();
    if (tid < 64) sEGE[tid] = EXPF(sG[63] - sG[tid]);
#pragma unroll
    for (int i = 0; i < 2; ++i) {
        const int idx = tid + 512 * i, c = idx >> 4, d0 = 8 * (idx & 15);
#pragma unroll
        for (int which = 0; which < 3; ++which) {
            const int wcol = which * 1024 + h * 128 + d0;
            const u32x4 r0 = rr[i][which][0], r1 = rr[i][which][1], r2 = rr[i][which][2], r3 = rr[i][which][3];
            float o[8]; float ss = 0.f;
#pragma unroll
            for (int q = 0; q < 2; ++q) { const f32x4 w0 = *(const gf32x4*)(cw + wcol + 4 * q), w1 = *(const gf32x4*)(cw + 3072 + wcol + 4 * q), w2 = *(const gf32x4*)(cw + 2 * 3072 + wcol + 4 * q), w3 = *(const gf32x4*)(cw + 3 * 3072 + wcol + 4 * q);
#pragma unroll
                for (int e = 0; e < 4; ++e) { const int j = 4 * q + e; const unsigned a3 = r3[j >> 1], a2 = r2[j >> 1], a1 = r1[j >> 1], a0 = r0[j >> 1];
                    const float x3 = (j & 1) ? bfhi(a3) : bflo(a3), x2 = (j & 1) ? bfhi(a2) : bflo(a2), x1 = (j & 1) ? bfhi(a1) : bflo(a1), x0 = (j & 1) ? bfhi(a0) : bflo(a0);
                    o[j] = silu_f(w0[e] * x3 + w1[e] * x2 + w2[e] * x1 + w3[e] * x0); ss += o[j] * o[j]; } }
            if (which == 2) {
                *(lf32x4*)(VF + c * FS + d0) = (f32x4){o[0], o[1], o[2], o[3]}; *(lf32x4*)(VF + c * FS + d0 + 4) = (f32x4){o[4], o[5], o[6], o[7]};
            } else {
                ss = sum16_f(ss);
                const float sc = (which == 0 ? 0.08838834764831845f : 1.0f) * rsqrt_f(ss + EPS);
#pragma unroll
                for (int j = 0; j < 8; ++j) o[j] *= sc;
                u32x4 pb; pb.x = pk2(o[0], o[1]); pb.y = pk2(o[2], o[3]); pb.z = pk2(o[4], o[5]); pb.w = pk2(o[6], o[7]);
                if (which == 0) {
                    *(lu32x4*)(QB + c * BS + d0) = pb;
                    const float eg = sEG[c]; u32x4 qd; qd.x = pk2(o[0] * eg, o[1] * eg); qd.y = pk2(o[2] * eg, o[3] * eg); qd.z = pk2(o[4] * eg, o[5] * eg); qd.w = pk2(o[6] * eg, o[7] * eg);
                    *(gu32x4*)(rec + CB_QD + (size_t)(c * 128 + d0) * 2) = qd;
                } else {
                    *(lu32x4*)(KB + c * BS + d0) = pb;
                    *(lf32x4*)(KF + c * FS + d0) = (f32x4){o[0], o[1], o[2], o[3]}; *(lf32x4*)(KF + c * FS + d0 + 4) = (f32x4){o[4], o[5], o[6], o[7]};
                }
            }
        }
    }
    SYNC();
    {
        const int type = w >> 2, ct = w & 3, r = lane & 15, kg = lane >> 4; const lbf16* As = type == 0 ? KB : QB; gbf16* pm = (gbf16*)(rec + CB_PM);
        bf16x8 af[4];
#pragma unroll
        for (int s = 0; s < 4; ++s) af[s] = *(const lbf16x8*)(As + (ct * 16 + r) * BS + 32 * s + 8 * kg);
        for (int mt = 0; mt < 4; ++mt) {
            f32x4 acc = (f32x4){0.f, 0.f, 0.f, 0.f};
            if (mt <= ct) {
                bf16x8 bq[4];
#pragma unroll
                for (int s = 0; s < 4; ++s) bq[s] = *(const lbf16x8*)(KB + (mt * 16 + r) * BS + 32 * s + 8 * kg);
#pragma unroll
                for (int s = 0; s < 4; ++s) acc = mfma16(af[s], bq[s], acc);
            }
            const int mi = mt * 16 + r;
            if (mt <= ct) {
#pragma unroll
                for (int j = 0; j < 4; ++j) { const int ci = ct * 16 + 4 * kg + j; const float dec = (mi <= ci) ? EXPF(sG[ci] - sG[mi]) : 0.f;
                    if (type == 0) AM[ci * AS + mi] = (mi < ci) ? -(sBeta[ci] * dec * acc[j]) : 0.f;
                    else pm[ci * 64 + mi] = (bf16)bf1(acc[j] * dec); }
            } else if (type != 0) {
#pragma unroll
                for (int j = 0; j < 4; ++j) pm[(ct * 16 + 4 * kg + j) * 64 + mi] = (bf16)0;
            }
        }
        if (type == 0) {
            WAVE_FENCE();
            lf32* Nd = AM + (ct * 16) * AS + ct * 16;
            float x[16];
#pragma unroll
            for (int i = 0; i < 16; ++i) x[i] = (i == r) ? 1.f : 0.f;
#pragma unroll
            for (int i = 1; i < 16; ++i) {
                float s0 = x[i], s1 = 0.f;
#pragma unroll
                for (int q = 0; q < (i + 3) / 4; ++q) { const f32x4 a = *(const lf32x4*)(Nd + i * AS + 4 * q);
#pragma unroll
                    for (int e = 0; e < 4; ++e) if (4 * q + e < i) { if (e & 1) s1 += a[e] * x[4 * q + e]; else s0 += a[e] * x[4 * q + e]; } }
                x[i] = s0 + s1;
            }
            WAVE_FENCE();
#pragma unroll
            for (int i = 0; i < 16; ++i) if ((i >> 2) == kg) Nd[i * AS + r] = x[i];
        }
    }
    SYNC();
#ifndef HOSTSIM
    if (itn >= 0 && w < 7) {
        const int row0n = (itn >> 8) * T + (itn & 31) * CH, hn = (itn >> 5) & 7;
        const gu8* gb = w < 6 ? (const gu8*)(p.PROJ + (size_t)row0n * NPJ + PC_QKV + (w >> 1) * 1024 + hn * 128) : (const gu8*)(p.AB + (size_t)row0n * 16);
        const unsigned vo = w < 6 ? (unsigned)((32 * (w & 1) + (lane >> 1)) * (NPJ * 2) + 128 * (lane & 1)) : (unsigned)(lane * 64);
        unsigned keep; asm volatile("s_mov_b32 %0, m0\n\ts_mov_b32 m0, %2\n\ts_nop 0\n\tglobal_load_lds_dwordx4 %1, %3\n\ts_mov_b32 m0, %0" : "=&s"(keep) : "v"(vo), "s"((unsigned)(size_t)(lds + L1_QB) + 1024u * (unsigned)w), "s"(gb) : "memory");
    }
#endif
    {
        const int kk_ = tid >> 2, c0 = 16 * (tid & 3); unsigned o[8];
#pragma unroll
        for (int i = 0; i < 8; ++i) o[i] = pk2(KF[(c0 + 2 * i) * FS + kk_] * sEGE[c0 + 2 * i], KF[(c0 + 2 * i + 1) * FS + kk_] * sEGE[c0 + 2 * i + 1]);
        gu32x4* dst = (gu32x4*)(rec + CB_KET + (size_t)(kk_ * 64 + c0) * 2);
        dst[0] = (u32x4){o[0], o[1], o[2], o[3]}; dst[1] = (u32x4){o[4], o[5], o[6], o[7]};
    }
    {
        const int r = lane & 15, g = lane >> 4; const bool isv = w < 4;
        bf16x4 Mf[4][4];
#pragma unroll
        for (int I = 0; I < 4; ++I)
#pragma unroll
            for (int J = 0; J <= I; ++J) { const f32x4 m = *(const lf32x4*)(AM + (16 * I + r) * AS + 16 * J + 4 * g); const u32x2 t = {pk2(m[0], m[1]), pk2(m[2], m[3])}; Mf[I][J] = __builtin_bit_cast(bf16x4, t); }
        f32x4 acc[2][4]; f32x4 sol[2][4]; bf16x4 solb[2][4];
#pragma unroll
        for (int I = 0; I < 4; ++I) {
            const f32x4 be = *(const lf32x4*)(sBeta + 16 * I + 4 * g), eg = *(const lf32x4*)(sEG + 16 * I + 4 * g);
#pragma unroll
            for (int ctl = 0; ctl < 2; ++ctl) {
                const lf32* src = isv ? VF + (32 * w + 16 * ctl + r) : KF + (32 * w + 16 * ctl + r - 128);
#pragma unroll
                for (int rr = 0; rr < 4; ++rr) acc[ctl][I][rr] = (isv ? be[rr] : be[rr] * eg[rr]) * src[(16 * I + 4 * g + rr) * FS];
            }
        }
#pragma unroll
        for (int I = 0; I < 4; ++I) {
#pragma unroll
            for (int J = 0; J < I; ++J)
#pragma unroll
                for (int ctl = 0; ctl < 2; ++ctl) acc[ctl][I] = mfma16k(Mf[I][J], solb[ctl][J], acc[ctl][I]);
#pragma unroll
            for (int ctl = 0; ctl < 2; ++ctl) { const u32x2 t = {pk2(acc[ctl][I][0], acc[ctl][I][1]), pk2(acc[ctl][I][2], acc[ctl][I][3])};
                sol[ctl][I] = mfma16k(Mf[I][I], __builtin_bit_cast(bf16x4, t), (f32x4){0.f, 0.f, 0.f, 0.f});
                const u32x2 t2 = {pk2(sol[ctl][I][0], sol[ctl][I][1]), pk2(sol[ctl][I][2], sol[ctl][I][3])}; solb[ctl][I] = __builtin_bit_cast(bf16x4, t2); }
        }
#pragma unroll
        for (int ctl = 0; ctl < 2; ++ctl) {
            const int col = 32 * w + 16 * ctl + r;
            if (isv) {
#pragma unroll
                for (int I = 0; I < 4; ++I) { u32x2 ub; ub.x = pk2(sol[ctl][I][0], sol[ctl][I][1]); ub.y = pk2(sol[ctl][I][2], sol[ctl][I][3]); *(gu32x2*)(rec + CB_UBT + ((size_t)col * 64 + 16 * I + 4 * g) * 2) = ub; }
            } else {
#pragma unroll
                for (int I = 0; I < 4; ++I)
#pragma unroll
                    for (int rr = 0; rr < 4; ++rr) WST[(16 * I + 4 * g + rr) * 128 + col - 128] = (bf16)bf1(-sol[ctl][I][rr]);
            }
        }
    }
    SYNC();
    {
        const lu32x4* s = (const lu32x4*)WST; gu32x4* dst = (gu32x4*)(rec + CB_WMN);
        dst[tid] = s[tid]; dst[tid + 512] = s[tid + 512];
        if (tid == 0) *(gf32*)(rec + CB_GE) = EXPF(sG[63]);
    }
    SYNC();
}

constexpr int L2_WM = 0, L2_QD = 17408, L2_KET = 34816, L2_PM = 53248, L2_OPS = 62464, L2_SBX = 2 * L2_OPS, L2_UBX = L2_SBX + 8192, L2_OT = L2_UBX + 4096, L2_PS = L2_OT + 5120;
constexpr int KS2 = 72, OTS = 40;
constexpr int L2_TOUCH = L2_PS + 512;
static_assert(L2_TOUCH + 2048 <= LDS_BYTES - 256, "scan LDS map");
DI void mx2_scan_item(const P& p, int l, int item, lu8* lds) {
    const int tid = TID, lane = tid & 63, w = WAVE_OF(tid), r = lane & 15, kg = lane >> 4;
    const int bh = item >> 2, vq = item & 3, b = bh >> 3, h = bh & 7, vt = w & 1, j = w >> 1, vl = 16 * vt + r, v = 32 * vq + vl;
    lu32x4* SBX = (lu32x4*)(lds + L2_SBX); lu8* UBX = lds + L2_UBX; lbf16* OT = (lbf16*)(lds + L2_OT); lf32* PS = (lf32*)(lds + L2_PS);
    const gu8* rec0 = p.MXB + (size_t)(bh * NCH) * CHB;
    const int q0 = tid, q1 = tid + 512;
    gbf16* og = p.ORAW + (size_t)(b * T) * DC + 128 * h + 32 * vq;
    gf32* pg = p.PSS + ((size_t)(b * T) * H + h) * 4 + vq;
    f32x4 ST2[2];
    ST2[0] = (f32x4){0.f, 0.f, 0.f, 0.f}; ST2[1] = ST2[0];
    u32x4 pw0, pw1, pq0, pq1, pk0, pk1, pp; u32x2 Un; float gen;
#define MX2_LOAD(n_) do { const gu8* _r = rec0 + (size_t)(n_) * CHB; \
        pw0 = *(const gu32x4*)(_r + CB_WMN + q0 * 16); pw1 = *(const gu32x4*)(_r + CB_WMN + q1 * 16); \
        pq0 = *(const gu32x4*)(_r + CB_QD + q0 * 16); pq1 = *(const gu32x4*)(_r + CB_QD + q1 * 16); \
        pk0 = *(const gu32x4*)(_r + CB_KET + q0 * 16); pk1 = *(const gu32x4*)(_r + CB_KET + q1 * 16); \
        pp = *(const gu32x4*)(_r + CB_PM + q0 * 16); \
        Un = *(const gu32x2*)(_r + CB_UBT + (size_t)(v * 64 + 16 * j + 4 * kg) * 2); \
        gen = *(const gf32*)(_r + CB_GE); } while (0)
#define MX2_STORE(set_) do { lu8* _b = lds + (set_) * L2_OPS; lbf16* _wm = (lbf16*)(_b + L2_WM); lbf16* _qd = (lbf16*)(_b + L2_QD); lbf16* _ke = (lbf16*)(_b + L2_KET); lbf16* _pm = (lbf16*)(_b + L2_PM); \
        *(lu32x4*)(_wm + (q0 >> 4) * BS + (q0 & 15) * 8) = pw0; *(lu32x4*)(_wm + (q1 >> 4) * BS + (q1 & 15) * 8) = pw1; \
        *(lu32x4*)(_qd + (q0 >> 4) * BS + (q0 & 15) * 8) = pq0; *(lu32x4*)(_qd + (q1 >> 4) * BS + (q1 & 15) * 8) = pq1; \
        *(lu32x4*)(_ke + (q0 >> 3) * KS2 + (q0 & 7) * 8) = pk0; *(lu32x4*)(_ke + (q1 >> 3) * KS2 + (q1 & 7) * 8) = pk1; \
        *(lu32x4*)(_pm + (q0 >> 3) * KS2 + (q0 & 7) * 8) = pp; } while (0)
    MX2_LOAD(0); MX2_STORE(0);
    SBX[(vt * 4 + j) * 64 + lane] = (u32x4){0u, 0u, 0u, 0u};
#define MX2_UEXP() (f32x4){bflo(Un.x), bfhi(Un.x), bflo(Un.y), bfhi(Un.y)}
    f32x4 U = MX2_UEXP(); float ge = gen;
    if (NCH > 1) MX2_LOAD(1);
    LDS_BARRIER();
    for (int n = 0; n < NCH; ++n) {
#ifndef HOSTSIM
        if (n + 3 < NCH) {
            const int L = w * 64 + lane; const gu8* r3 = rec0 + (size_t)(n + 3) * CHB;
            const unsigned vo = L < 448 ? (unsigned)(CB_WMN + L * 128) : (unsigned)(CB_UBT + (32 * vq + ((L - 448) & 31)) * 128);
            unsigned keep; asm volatile("s_mov_b32 %0, m0\n\ts_mov_b32 m0, %2\n\ts_nop 0\n\tglobal_load_lds_dword %1, %3\n\ts_mov_b32 m0, %0" : "=&s"(keep) : "v"(vo), "s"((unsigned)(size_t)(lds + L2_TOUCH) + 256u * (unsigned)w), "s"(r3) : "memory"); }
#endif
        const lu8* ob = lds + (n & 1) * L2_OPS; const lbf16* WM = (const lbf16*)(ob + L2_WM); const lbf16* QD = (const lbf16*)(ob + L2_QD); const lbf16* KET = (const lbf16*)(ob + L2_KET); const lbf16* PM = (const lbf16*)(ob + L2_PM);
        bf16x8 SB[4], Af[4], Aq[4];
#pragma unroll
        for (int s = 0; s < 4; ++s) { SB[s] = __builtin_bit_cast(bf16x8, SBX[(vt * 4 + s) * 64 + lane]);
            Af[s] = frag2(WM, (16 * j + r) * BS + 32 * s + 4 * kg, (16 * j + r) * BS + 32 * s + 16 + 4 * kg);
            Aq[s] = frag2(QD, (16 * j + r) * BS + 32 * s + 4 * kg, (16 * j + r) * BS + 32 * s + 16 + 4 * kg); }
        f32x4 O = (f32x4){0.f, 0.f, 0.f, 0.f};
#pragma unroll
        for (int s = 0; s < 4; ++s) { U = mfma16(Af[s], SB[s], U); O = mfma16(Aq[s], SB[s], O); }
        { u32x2 uh; uh.x = pk2(U[0], U[1]); uh.y = pk2(U[2], U[3]); *(lu32x2*)(UBX + ((vt * 2 + (j >> 1)) * 64 + lane) * 16 + (j & 1) * 8) = uh; }
        LDS_BARRIER();
        bf16x8 UB[2], Ap[2], Ak[4];
#pragma unroll
        for (int s = 0; s < 2; ++s) { UB[s] = __builtin_bit_cast(bf16x8, *(const lu32x4*)(UBX + ((vt * 2 + s) * 64 + lane) * 16));
            Ap[s] = frag2(PM, (16 * j + r) * KS2 + 32 * s + 4 * kg, (16 * j + r) * KS2 + 32 * s + 16 + 4 * kg);
            Ak[s] = frag2(KET, (16 * (2 * j) + r) * KS2 + 32 * s + 4 * kg, (16 * (2 * j) + r) * KS2 + 32 * s + 16 + 4 * kg);
            Ak[2 + s] = frag2(KET, (16 * (2 * j + 1) + r) * KS2 + 32 * s + 4 * kg, (16 * (2 * j + 1) + r) * KS2 + 32 * s + 16 + 4 * kg); }
        ST2[0] = ST2[0] * ge; ST2[1] = ST2[1] * ge;
#pragma unroll
        for (int s = 0; s < 2; ++s) { ST2[0] = mfma16(Ak[s], UB[s], ST2[0]); ST2[1] = mfma16(Ak[2 + s], UB[s], ST2[1]); O = mfma16(Ap[s], UB[s], O); }
        SBX[(vt * 4 + j) * 64 + lane] = __builtin_bit_cast(u32x4, pack8(ST2[0], ST2[1]));
#pragma unroll
        for (int jj = 0; jj < 4; ++jj) { const int c = 16 * j + 4 * kg + jj; OT[c * OTS + vl] = (bf16)bf1(O[jj]); const float q = sum16_f(O[jj] * O[jj]); if (r == 0) PS[c * 2 + vt] = q; }
        if (n + 1 < NCH) { MX2_STORE((n + 1) & 1); U = MX2_UEXP(); ge = gen; }
        if (n + 2 < NCH) MX2_LOAD(n + 2);
        LDS_BARRIER();
        if (tid < 256) *(gu32x4*)(og + (size_t)(n * CH + (tid >> 2)) * DC + (tid & 3) * 8) = *(const lu32x4*)(OT + (tid >> 2) * OTS + (tid & 3) * 8);
        else if (tid < 320) { const int c = tid - 256; pg[(size_t)(n * CH + c) * 32] = PS[c * 2] + PS[c * 2 + 1]; }
    }
#undef MX2_LOAD
#undef MX2_UEXP
#undef MX2_STORE
    gf32* dst = p.out + O_DL_P + ((size_t)((l * NB + b) * H + h) * DV + v) * DK;
    *(gf32x4*)(dst + 16 * (2 * j) + 4 * kg) = ST2[0]; *(gf32x4*)(dst + 16 * (2 * j + 1) + 4 * kg) = ST2[1];
    SYNC();
}
DI void mx3_finish(const P& p, int l) {
    const int tid = TID, lane = tid & 63, gw = BID * NWAVES + WAVE_OF(tid), ngw = GRID * NWAVES;
    const int c0 = 16 * lane, hh = lane >> 3;
    float wv[16];
#pragma unroll
    for (int q = 0; q < 4; ++q) { const f32x4 a = *(const gf32x4*)(p.dn_norm_w + l * DV + (c0 & 127) + 4 * q); wv[4 * q] = a[0]; wv[4 * q + 1] = a[1]; wv[4 * q + 2] = a[2]; wv[4 * q + 3] = a[3]; }
    for (int m = gw; m < MP; m += ngw) {
        const u32x4 o0 = *(const gu32x4*)(p.ORAW + (size_t)m * DC + c0), o1 = *(const gu32x4*)(p.ORAW + (size_t)m * DC + c0 + 8);
        const u32x4 z0 = *(const gu32x4*)(p.PROJ + (size_t)m * NPJ + PC_Z + c0), z1 = *(const gu32x4*)(p.PROJ + (size_t)m * NPJ + PC_Z + c0 + 8);
        const f32x4 ps = *(const gf32x4*)(p.PSS + ((size_t)m * H + hh) * 4);
        const float rs = rsqrt_f(((ps[0] + ps[1]) + (ps[2] + ps[3])) * (1.0f / DV) + EPS);
        u32x4 r0, r1;
#pragma unroll
        for (int e = 0; e < 4; ++e) {
            r0[e] = pk2(bflo(o0[e]) * rs * wv[2 * e] * silu_f(bflo(z0[e])), bfhi(o0[e]) * rs * wv[2 * e + 1] * silu_f(bfhi(z0[e])));
            r1[e] = pk2(bflo(o1[e]) * rs * wv[8 + 2 * e] * silu_f(bflo(z1[e])), bfhi(o1[e]) * rs * wv[8 + 2 * e + 1] * silu_f(bfhi(z1[e]))); }
        *(gu32x4*)(p.MIX + (size_t)m * D + DC + c0) = r0; *(gu32x4*)(p.MIX + (size_t)m * D + DC + c0 + 8) = r1;
    }
}
constexpr int SMP_LDS = 16640;
DI void mx2_sample_item(const P& p, int l, int it, lu8* lds, int wave, int lane) {
    const int sb = it >> 3, h = it & 7, m0 = MP + 4 * sb;
    lf32* QKV = (lf32*)(lds + wave * SMP_LDS);
    lf32* OO = QKV + 1536;
    lf32* sEG = OO + 512, *sBeta = sEG + 4;
    const gf32* cw = p.conv_qkv_w + (size_t)l * 4 * 3072;
#pragma unroll
    for (int i = 0; i < 6; ++i) {
        const int j = lane + 64 * i, which = j >> 7, d = j & 127, col = which * 1024 + h * 128 + d;
        const float w0 = cw[col], w1 = cw[3072 + col], w2 = cw[2 * 3072 + col], w3 = cw[3 * 3072 + col];
        const gf32* st = p.st_conv_qkv + ((size_t)(l * SB + sb) * 3) * 3072 + col;
        float x3 = st[0], x2 = st[3072], x1 = st[2 * 3072];
#pragma unroll
        for (int t = 0; t < 4; ++t) { const float x0 = bf2f(p.PROJ[(size_t)(m0 + t) * NPJ + PC_QKV + col]); QKV[(which * 4 + t) * 128 + d] = silu_f(w0 * x3 + w1 * x2 + w2 * x1 + w3 * x0); x3 = x2; x2 = x1; x1 = x0; }
    }
    if (lane < 4) { const float a = p.AB[(size_t)(m0 + lane) * 16 + h], bb = p.AB[(size_t)(m0 + lane) * 16 + 8 + h];
        sEG[lane] = EXPF(-EXPF(p.a_log[l * H + h]) * softplus_f(a + p.dt_bias[l * H + h])); sBeta[lane] = sigmoid_f(bb); }
    WAVE_FENCE();
#pragma unroll
    for (int rw = 0; rw < 8; ++rw) {
        lf32* row = QKV + rw * 128; const float a = row[lane], c = row[lane + 64]; const float ss = wave_sum(a * a + c * c);
        const float sc = (rw < 4 ? 0.08838834764831845f : 1.0f) * rsqrt_f(ss + EPS); row[lane] = a * sc; row[lane + 64] = c * sc;
    }
    WAVE_FENCE();
    const int vr = lane >> 2, pp = lane & 3;
    const gf32* sin = p.st_delta + ((size_t)((l * SB + sb) * H + h) * DV + vr) * DK + 4 * pp;
    gf32* sout = p.out + O_DL_S + ((size_t)((l * SB + sb) * H + h) * DV + vr) * DK + 4 * pp;
    f32x4 Sn[8];
#pragma unroll
    for (int i = 0; i < 8; ++i) Sn[i] = *(const gf32x4*)(sin + 16 * i);
    for (int ps = 0; ps < 8; ++ps) {
        f32x4 S[8];
#pragma unroll
        for (int i = 0; i < 8; ++i) S[i] = Sn[i];
        if (ps + 1 < 8) {
#pragma unroll
            for (int i = 0; i < 8; ++i) Sn[i] = *(const gf32x4*)(sin + (size_t)(ps + 1) * 16 * DK + 16 * i);
        }
        const int vv = 16 * ps + vr;
#pragma unroll
        for (int t = 0; t < 4; ++t) {
            const float eg = sEG[t], be = sBeta[t]; const lf32* kt = QKV + (4 + t) * 128 + 4 * pp; const lf32* qt = QKV + t * 128 + 4 * pp; float rr = 0.f;
            f32x4 kv[8];
#pragma unroll
            for (int i = 0; i < 8; ++i) { kv[i] = *(const lf32x4*)(kt + 16 * i); S[i] = S[i] * eg; rr += (S[i][0] * kv[i][0] + S[i][1] * kv[i][1]) + (S[i][2] * kv[i][2] + S[i][3] * kv[i][3]); }
            rr = sum4_f(rr);
            const float dl = be * (QKV[(8 + t) * 128 + vv] - rr); float oo = 0.f;
#pragma unroll
            for (int i = 0; i < 8; ++i) { const f32x4 qv = *(const lf32x4*)(qt + 16 * i); S[i] = S[i] + kv[i] * dl; oo += (S[i][0] * qv[0] + S[i][1] * qv[1]) + (S[i][2] * qv[2] + S[i][3] * qv[3]); }
            oo = sum4_f(oo);
            if (pp == 0) OO[t * 128 + vv] = oo;
        }
#pragma unroll
        for (int i = 0; i < 8; ++i) *(gf32x4*)(sout + (size_t)ps * 16 * DK + 16 * i) = S[i];
    }
    WAVE_FENCE();
#pragma unroll
    for (int t = 0; t < 4; ++t) {
        const float a = OO[t * 128 + lane], c = OO[t * 128 + lane + 64]; const float ss = wave_sum(a * a + c * c); const float rs = rsqrt_f(ss * (1.0f / DV) + EPS);
        const size_t m = (size_t)(m0 + t);
        const float z0 = bf2f(p.PROJ[m * NPJ + PC_Z + 128 * h + lane]), z1 = bf2f(p.PROJ[m * NPJ + PC_Z + 128 * h + lane + 64]);
        p.MIX[m * D + DC + 128 * h + lane] = (bf16)bf1(a * rs * p.dn_norm_w[l * DV + lane] * silu_f(z0));
        p.MIX[m * D + DC + 128 * h + lane + 64] = (bf16)bf1(c * rs * p.dn_norm_w[l * DV + lane + 64] * silu_f(z1));
    }
    WAVE_FENCE();
}
#ifndef REPK
#define REPK -1
#endif
#define SUBREP(bit) (((REPK >= 0) && ((REPK >> (bit)) & 1)) ? 2 : 1)
DI void mx2_phase(const P& p, int l, lu8* lds) {
    const int G = GRID, bid = BID;
    constexpr int NSC = NB * H * 4;
    if (G > NSC) {
        if (bid < NSC) { const int item = ((bid & 7) + 8 * (bid >> 5)) * 4 + ((bid >> 3) & 3);
            for (int rp = 0; rp < SUBREP(10); ++rp) mx2_scan_item(p, l, item, lds); }
        else { const int tid = TID, lane = tid & 63, wave = WAVE_OF(tid), nwg = G - NSC, wi = wave * nwg + (bid - NSC), nw = nwg * NWAVES;
            for (int rp = 0; rp < SUBREP(11); ++rp) for (int it = wi; it < SB * H; it += nw) mx2_sample_item(p, l, it, lds, wave, lane);
            if (CONV_IN_MX2 && l + 1 < DEPTH) convert_layer(p, l + 1, lds, wi, nw, wave, lane, 0, CONV_SPLIT); }
    } else {
        for (int it = bid; it < NSC; it += G) mx2_scan_item(p, l, it, lds);
        const int tid = TID, lane = tid & 63, wave = WAVE_OF(tid), wi = bid * NWAVES + wave, nw = G * NWAVES;
        for (int it = wi; it < SB * H; it += nw) mx2_sample_item(p, l, it, lds, wave, lane);
    }
}
DI void mx3_phase(const P& p, int l, lu8* lds) {
    mx3_finish(p, l);
    if (CONV_IN_MX2 && l + 1 < DEPTH) { const int tid = TID, lane = tid & 63, wave = WAVE_OF(tid);
        for (int rp = 0; rp < SUBREP(12); ++rp) convert_layer(p, l + 1, lds, BID * NWAVES + wave, GRID * NWAVES, wave, lane, (GRID > NB * H * 4) ? CONV_SPLIT : 0, IT_LAYER); }
}
#ifndef HOSTSIM
constexpr int NPL = 7, N_PHASES = 2 + NPL * DEPTH;
constexpr int CW_BAR = 4096;
constexpr int MISC_OFF = LDS_BYTES - 64, PRM_OFF = LDS_BYTES - 256;
struct Args { const float* in[18]; float* out; unsigned char* ws; int ph_lo, ph_hi; };
__global__ void __launch_bounds__(NWAVES * 64, 2) fwd(Args args) {
    extern __shared__ __attribute__((aligned(16))) unsigned char lds[];
    const int tid = threadIdx.x;
    const int G = gridDim.x, bid = blockIdx.x;
    LAS unsigned char* ldsl = (LAS unsigned char*)lds;
    volatile LAS unsigned* MISC = (volatile LAS unsigned*)(ldsl + MISC_OFF);
    if (tid < 16) MISC[tid] = 0u;
    if (tid < 20) { const unsigned long long v = tid < 18 ? (unsigned long long)args.in[tid] : (tid == 18 ? (unsigned long long)args.out : (unsigned long long)args.ws);
        ((LAS unsigned long long*)(ldsl + PRM_OFF))[tid] = v; }
    __syncthreads();
    const int lo = args.ph_lo, hi = args.ph_hi;
    unsigned* ctl = (unsigned*)(args.ws + WS_CTL);
    XcdBarrier bar; bar.bar = ctl + CW_BAR; bar.x = 0; bar.st = nullptr;
    if (hi - lo > 1) bar = xcd_barrier_post(ctl + CW_BAR, MISC + 8);
#ifndef REPK
#define REPK -1
#endif
#define NREP(kind) (((REPK >= 0) && ((REPK >> (kind)) & 1)) ? 2 : 1)
#ifndef PHMASK
#define PHMASK 0x1ff
#endif
#define EN(kind) ((PHMASK >> (kind)) & 1)
#define IN(k) (lo <= (k) && (k) < hi)
#define LOADP() P p; { int _o = PRM_OFF; asm volatile("" : "+v"(_o)); const LAS unsigned long long* _q = (const LAS unsigned long long*)(ldsl + _o); \
        unsigned long long _v[20]; _Pragma("unroll") for (int _i = 0; _i < 20; ++_i) { const unsigned long long _t = _q[_i]; _v[_i] = ((unsigned long long)(unsigned)__builtin_amdgcn_readfirstlane((int)(_t >> 32)) << 32) | (unsigned)__builtin_amdgcn_readfirstlane((int)_t); } \
        p.x_prompt = (const gf32*)_v[0]; p.x_sample = (const gf32*)_v[1]; p.st_conv_a = (const gf32*)_v[2]; p.st_conv_qkv = (const gf32*)_v[3]; p.st_delta = (const gf32*)_v[4]; p.norm_mix_w = (const gf32*)_v[5]; p.w_in = (const gf32*)_v[6]; \
        p.conv_a_w = (const gf32*)_v[7]; p.conv_a_norm_w = (const gf32*)_v[8]; p.conv_qkv_w = (const gf32*)_v[9]; p.a_log = (const gf32*)_v[10]; p.dt_bias = (const gf32*)_v[11]; p.dn_norm_w = (const gf32*)_v[12]; p.w_out = (const gf32*)_v[13]; \
        p.norm_ffn_w = (const gf32*)_v[14]; p.w_up = (const gf32*)_v[15]; p.w_down = (const gf32*)_v[16]; p.final_norm_w = (const gf32*)_v[17]; p.out = (gf32*)_v[18]; p.ws = (gu8*)_v[19]; \
        p.X = (gf32*)(p.ws + WS_X); p.XB = (gbf16*)(p.ws + WS_XB); p.SSQ = (gf32*)(p.ws + WS_SSQ); p.PROJ = (gbf16*)(p.ws + WS_PROJ); p.AB = (gf32*)(p.ws + WS_AB); \
        p.MIX = (gbf16*)(p.ws + WS_MIX); p.UP = (gbf16*)(p.ws + WS_UP); p.MXB = p.ws + WS_MXB; p.ORAW = (gbf16*)(p.ws + WS_ORAW); p.PSS = (gf32*)(p.ws + WS_PSS); }
#define SEAM(k) do { if (IN(k) && IN((k) + 1)) { xcd_barrier(bar); if (REPK >= 0 && ((REPK >> 9) & 1)) xcd_barrier(bar); } } while (0)

    if (EN(0) && IN(0)) _Pragma("nounroll") for (int rep = 0; rep < NREP(0); ++rep) { LOADP(); p0_prologue(p, ldsl); if (rep == NREP(0) - 1) SEAM(0); }
    for (int l = 0; l < DEPTH; ++l) {
        const int pb = 1 + NPL * l;
        if (EN(2) && IN(pb + 0)) _Pragma("nounroll") for (int rep = 0; rep < NREP(2); ++rep) {
            LOADP(); const gu8* wl = p.ws + WS_W + (size_t)l * WL_BYTES; pg8::Gemm g{(const bf16*)p.XB, (const bf16*)(p.XB + (size_t)MP * D), (const bf16*)(wl + WL_IN), M, NPAD, D}; pg8::StaticOrder S; S.init(M, NPAD, G, bid);
            pg8::EpiProj E{p.PROJ, p.AB, p.SSQ + (size_t)(2 * l) * SSQ_ARR};
            pg8::gemm_phase<pg8::EpiProj, pg8::StaticOrder, true, true, false>(ldsl, g, S, E);
            if (rep == NREP(2) - 1) SEAM(pb + 0);
        }
        if (EN(3) && IN(pb + 1)) _Pragma("nounroll") for (int rep = 0; rep < NREP(3); ++rep) {
            LOADP();
            for (int rp = 0; rp < SUBREP(13); ++rp) for (int it = bid; it < NB * H * NCH; it += G) mx1_chunk_item(p, l, it, it + G < NB * H * NCH ? it + G : -1, ldsl);
            for (int rp = 0; rp < SUBREP(14); ++rp) mx1_conva_phase(p, l);
            for (int rp = 0; rp < SUBREP(15); ++rp) mx1_convstate_copy(p, l);
            if (rep == NREP(3) - 1) SEAM(pb + 1);
        }
        if (EN(4) && IN(pb + 2)) _Pragma("nounroll") for (int rep = 0; rep < NREP(4); ++rep) {
            LOADP();
            mx2_phase(p, l, ldsl);
            if (rep == NREP(4) - 1) SEAM(pb + 2);
        }
        if (EN(1) && IN(pb + 3)) _Pragma("nounroll") for (int rep = 0; rep < NREP(1); ++rep) {
            LOADP();
            mx3_phase(p, l, ldsl);
            if (rep == NREP(1) - 1) SEAM(pb + 3);
        }
        if (EN(5) && IN(pb + 4)) _Pragma("nounroll") for (int rep = 0; rep < NREP(5); ++rep) {
            LOADP(); const gu8* wl = p.ws + WS_W + (size_t)l * WL_BYTES; pg8::Gemm g{(const bf16*)p.MIX, (const bf16*)(p.MIX + (size_t)MP * D), (const bf16*)(wl + WL_OUT), MP, D, D}; pg8::StaticOrder S; S.init(MP, D, G, bid);
            pg8::EpiRes E{p.XB, p.SSQ + (size_t)(2 * l + 1) * SSQ_ARR, D, rep == 0 ? 1.0f : (float)lo, (gf32*)nullptr};
            pg8::gemm_phase<pg8::EpiRes, pg8::StaticOrder, true, true>(ldsl, g, S, E);
            if (rep == NREP(5) - 1) SEAM(pb + 4);
        }
        if (EN(6) && IN(pb + 5)) _Pragma("nounroll") for (int rep = 0; rep < NREP(6); ++rep) {
            LOADP(); const gu8* wl = p.ws + WS_W + (size_t)l * WL_BYTES; pg8::Gemm g{(const bf16*)p.XB, (const bf16*)(p.XB + (size_t)MP * D), (const bf16*)(wl + WL_UP), MP, DFF, D}; pg8::StaticOrder S; S.init(MP, DFF, G, bid);
            pg8::EpiUp E{p.UP, DFF, p.SSQ + (size_t)(2 * l + 1) * SSQ_ARR};
#if defined(PROBE_NOXR)
            if (rep == 0) pg8::gemm_phase<pg8::EpiUp, pg8::StaticOrder, true, true>(ldsl, g, S, E); else pg8::gemm_phase<pg8::EpiUp, pg8::StaticOrder, true, true, false>(ldsl, g, S, E);
#else
            pg8::gemm_phase<pg8::EpiUp, pg8::StaticOrder, true, true>(ldsl, g, S, E);
#endif
            if (rep == NREP(6) - 1) SEAM(pb + 5);
        }
        if (EN(7) && IN(pb + 6)) _Pragma("nounroll") for (int rep = 0; rep < NREP(7); ++rep) {
            LOADP(); const gu8* wl = p.ws + WS_W + (size_t)l * WL_BYTES; pg8::Gemm g{(const bf16*)p.UP, (const bf16*)(p.UP + (size_t)MP * DFF), (const bf16*)(wl + WL_DOWN), MP, D, DFF}; pg8::StaticOrder S; S.init(MP, D, G, bid);
            pg8::EpiRes E{p.XB, p.SSQ + (size_t)(2 * l + 2) * SSQ_ARR, D, rep == 0 ? 1.0f : (float)lo, (gf32*)nullptr};
            pg8::gemm_phase<pg8::EpiRes, pg8::StaticOrder, true, true>(ldsl, g, S, E);
            if (rep == NREP(7) - 1) SEAM(pb + 6);
        }
    }
    if (EN(8) && IN(N_PHASES - 1)) _Pragma("nounroll") for (int rep = 0; rep < NREP(8); ++rep) { LOADP(); fin_phase(p); }
#undef IN
#undef SEAM
}

#ifndef MK_ONE_LAUNCH
#define MK_ONE_LAUNCH 1
#endif
extern "C" void kernel_launch(void* const* d_in, const int* in_sizes, int n_in, void* d_out, int out_size, void* d_ws, size_t ws_size, hipStream_t stream) {
    static int grid = 0;
    if (grid == 0) {
        if (n_in != 18 || (size_t)out_size != O_END || ws_size < WS_END) { fprintf(stderr, "kernel_launch: unexpected shapes (n_in %d out %d ws %zu)\n", n_in, out_size, ws_size); grid = -1; return; }
        int dev = 0, cus = 0, per_cu = 0;
        if (hipGetDevice(&dev) != hipSuccess || hipDeviceGetAttribute(&cus, hipDeviceAttributeMultiprocessorCount, dev) != hipSuccess) { grid = -1; return; }
        if (hipFuncSetAttribute((const void*)fwd, hipFuncAttributeMaxDynamicSharedMemorySize, LDS_BYTES) != hipSuccess) { fprintf(stderr, "kernel_launch: hipFuncSetAttribute failed\n"); grid = -1; return; }
        if (hipOccupancyMaxActiveBlocksPerMultiprocessor(&per_cu, (const void*)fwd, NWAVES * 64, LDS_BYTES) != hipSuccess || per_cu < 1) { fprintf(stderr, "kernel_launch: occupancy query says %d\n", per_cu); }
        (void)hipGetLastError();
        grid = cus;
    }
    if (grid < 0) return;
    if (hipMemsetAsync((char*)d_ws + WS_CTL, 0, CTL_BYTES, stream) != hipSuccess) return;
    Args a{};
    for (int i = 0; i < 18; ++i) a.in[i] = (const float*)d_in[i];
    a.out = (float*)d_out; a.ws = (unsigned char*)d_ws;
#if MK_ONE_LAUNCH
    a.ph_lo = 0; a.ph_hi = N_PHASES;
    hipLaunchKernelGGL(fwd, dim3(grid), dim3(NWAVES * 64), LDS_BYTES, stream, a);
#else
    for (int k = 0; k < N_PHASES; ++k) { a.ph_lo = k; a.ph_hi = k + 1; hipLaunchKernelGGL(fwd, dim3(grid), dim3(NWAVES * 64), LDS_BYTES, stream, a); }
#endif
}
#endif
```

```cpp
#ifndef HOSTSIM
#include <hip/hip_runtime.h>
#include <cstdio>
#include <cstdint>
#define DI __device__ __forceinline__
__device__ __forceinline__ int opaque_tid() { int t = threadIdx.x; asm volatile("" : "+v"(t)); return t; }
#define TID opaque_tid()
#define WAVE_OF(t) __builtin_amdgcn_readfirstlane((t) >> 6)
#define BID ((int)blockIdx.x)
#define GRID ((int)gridDim.x)
#define SYNC() __syncthreads()
#define GAS __attribute__((address_space(1)))
#define LAS __attribute__((address_space(3)))
#define WAVE_FENCE() asm volatile("s_waitcnt lgkmcnt(0)" ::: "memory")
#define EXPF(x) __expf(x)
#define LOGF(x) __logf(x)
#endif

typedef unsigned short bf16;
typedef short bf16x8 __attribute__((ext_vector_type(8)));
typedef short bf16x4 __attribute__((ext_vector_type(4)));
typedef float f32x4 __attribute__((ext_vector_type(4)));
typedef float f32x2 __attribute__((ext_vector_type(2)));
typedef unsigned u32x4 __attribute__((ext_vector_type(4)));
typedef unsigned u32x2 __attribute__((ext_vector_type(2)));

constexpr int D = 2048, DIN = 7184, NPJ = 7168, NPAD = 7424, DFF = 8192, DEPTH = 4;
constexpr int NB = 4, T = 2048, MP = NB * T, SB = 128, SL = 4, MS = SB * SL, M = MP + MS;
constexpr int H = 8, DK = 128, DV = 128, CH = 64, NCH = T / CH, DC = 1024, NG = 8, CG = 128;
constexpr float EPS = 1e-6f;
constexpr int PC_B = 0, PC_C = 1024, PC_H = 2048, PC_QKV = 3072, PC_Z = 6144;

constexpr size_t WS_CTL = 0, CTL_BYTES = 1u << 20;
constexpr size_t WL_IN = 0, WL_OUT = (size_t)NPAD * D * 2, WL_UP = WL_OUT + (size_t)D * D * 2, WL_DOWN = WL_UP + (size_t)DFF * D * 2, WL_BYTES = WL_DOWN + (size_t)D * DFF * 2;
constexpr size_t WS_W = CTL_BYTES;
constexpr size_t WS_X = WS_W + DEPTH * WL_BYTES;
constexpr size_t WS_XB = WS_X + (size_t)M * D * 4;
constexpr size_t WS_PROJ = WS_XB + (size_t)M * D * 2;
constexpr size_t WS_AB = WS_PROJ + (size_t)M * NPJ * 2;
constexpr size_t WS_MIX = WS_AB + (size_t)M * 16 * 4;
constexpr size_t WS_UP = WS_MIX + (size_t)M * D * 2;
constexpr size_t WS_MXB = WS_UP + (size_t)M * DFF * 2;
constexpr size_t CB_UBT = 0, CB_WMN = 16384, CB_QD = CB_WMN + 16384, CB_KET = CB_QD + 16384, CB_PM = CB_KET + 16384, CB_GE = CB_PM + 8192, CHB = CB_GE + 256;
constexpr size_t WS_SSQ = WS_MXB + (size_t)NB * H * NCH * CHB;
constexpr size_t SSQ_ARR = (size_t)8 * M * 8;
constexpr size_t WS_ORAW = WS_SSQ + (size_t)(2 * DEPTH + 1) * SSQ_ARR * 4;
constexpr size_t WS_PSS = WS_ORAW + (size_t)MP * DC * 2;
constexpr size_t WS_END = WS_PSS + (size_t)MP * H * 4 * 4;
static_assert(WS_END <= (size_t)1000 * 1024 * 1024, "d_ws map must stay under the guaranteed workspace");
constexpr size_t O_Y = 0, O_CA_P = (size_t)M * D, O_CQ_P = O_CA_P + (size_t)DEPTH * NB * 2 * DC, O_DL_P = O_CQ_P + (size_t)DEPTH * NB * 3 * 3072,
                 O_CA_S = O_DL_P + (size_t)DEPTH * NB * H * DV * DK, O_CQ_S = O_CA_S + (size_t)DEPTH * SB * 2 * DC, O_DL_S = O_CQ_S + (size_t)DEPTH * SB * 3 * 3072,
                 O_END = O_DL_S + (size_t)DEPTH * SB * H * DV * DK;
static_assert(O_END == 92979200ull, "output size");
constexpr int LDS_BYTES = 147456;
constexpr int NWAVES = 8;

DI unsigned f2bf(float f) { unsigned u = __builtin_bit_cast(unsigned, f); return (u + 0x7fffu + ((u >> 16) & 1u)) >> 16; }
DI float bf2f(unsigned b) { return __builtin_bit_cast(float, (b & 0xffffu) << 16); }
#ifdef HOSTSIM
DI unsigned pk2(float lo, float hi) { return f2bf(lo) | (f2bf(hi) << 16); }
DI float rsqrt_f(float x) { return 1.0f / sqrtf(x); }
DI float rcp_f(float x) { return 1.0f / x; }
#else
typedef __bf16 hwbf16x2 __attribute__((ext_vector_type(2)));
DI unsigned pk2(float lo, float hi) { const f32x2 v = {lo, hi}; const hwbf16x2 b = __builtin_convertvector(v, hwbf16x2); return __builtin_bit_cast(unsigned, b); }
DI float rsqrt_f(float x) { return __builtin_amdgcn_rsqf(x); }
DI float rcp_f(float x) { return __builtin_amdgcn_rcpf(x); }
#endif
DI unsigned bf1(float x) { return pk2(x, 0.f) & 0xffffu; }
DI float bflo(unsigned w) { return __builtin_bit_cast(float, w << 16); }
DI float bfhi(unsigned w) { return __builtin_bit_cast(float, w & 0xffff0000u); }
DI float silu_f(float x) { return x * rcp_f(1.0f + EXPF(-x)); }
DI float sigmoid_f(float x) { return rcp_f(1.0f + EXPF(-x)); }
DI float softplus_f(float x) { if (x > 20.f) return x; const float y = EXPF(x); return y < 0.03125f ? y * (1.0f - y * (0.5f - y * (0.33333334f - 0.25f * y))) : LOGF(1.0f + y); }
#ifndef HOSTSIM
DI float shfl_xor_f(float v, int m) { return __shfl_xor(v, m); }
DI float shfl_up_f(float v, int d) { return __shfl_up(v, d); }
DI f32x4 mfma16(bf16x8 a, bf16x8 b, f32x4 c) { return __builtin_amdgcn_mfma_f32_16x16x32_bf16(a, b, c, 0, 0, 0); }
DI f32x4 mfma16k(bf16x4 a, bf16x4 b, f32x4 c) { return __builtin_amdgcn_mfma_f32_16x16x16bf16_1k(a, b, c, 0, 0, 0); }
DI f32x4 mfma4(float a, float b, f32x4 c) { return __builtin_amdgcn_mfma_f32_16x16x4f32(a, b, c, 0, 0, 0); }
template <int CTRL> DI float dpp_f(float v) { return __builtin_bit_cast(float, __builtin_amdgcn_update_dpp(0, __builtin_bit_cast(int, v), CTRL, 0xF, 0xF, true)); }
DI float sum4_f(float v) { v += dpp_f<0xB1>(v); v += dpp_f<0x4E>(v); return v; }
DI float sum16_f(float v) { v = sum4_f(v); v += dpp_f<0x141>(v); v += dpp_f<0x140>(v); return v; }
#define LDS_BARRIER() do { asm volatile("s_waitcnt lgkmcnt(0)" ::: "memory"); __builtin_amdgcn_s_barrier(); asm volatile("" ::: "memory"); } while (0)
#endif
#ifndef HOSTSIM
namespace pg8 {
#define PG8_LAS __attribute__((address_space(3)))
typedef unsigned short bf16_t;
typedef short bf16x8 __attribute__((ext_vector_type(8)));
typedef float f32x4 __attribute__((ext_vector_type(4)));
typedef unsigned u32x4 __attribute__((ext_vector_type(4)));
constexpr int BM = 256, BK = 64, HALF = 128, HTB = HALF * BK * 2  , STAGE_BYTES = 8 * HTB, NXCD = 8, WGM = 8;

__host__ __device__ __forceinline__ int lds_byte(int r, int c) { const int st = (r >> 4) * 2 + (c >> 5), rr = r & 15, cc = c & 31, ob = rr * 64 + cc * 2; return st * 1024 + (ob ^ (((ob >> 9) & 1) << 5)); }
__host__ __device__ __forceinline__ void stage_rc(int b, int& R, int& C) { const int st = b / 1024, sb = b % 1024, swz = sb ^ (((sb >> 9) & 1) << 5); R = (st >> 1) * 16 + swz / 64; C = (st & 1) * 32 + (swz % 64) / 2; }
__host__ __device__ __forceinline__ int perm32(int rho) { const int n = rho >> 4, i = rho & 15; return 8 * (i >> 2) + 4 * n + (i & 3); }

struct Unit { int pm, pn; };
struct Gemm { const bf16_t* A; const bf16_t* Ax; const bf16_t* Bt; int M, N, K; };

struct StaticOrder {
    int nM, nN, nwg, G, c;
    __host__ __device__ void init(int M, int N, int G_, int c_) { nM = M / BM; nN = N / BM; nwg = nM * nN; G = G_; c = c_; }
    __host__ __device__ bool next(int i, Unit& u) const {
        const long L = (long)i * G + c; if (L >= nwg) return false;
        int wgid = (int)L; { const int q = nwg / NXCD, r = nwg % NXCD, xcd = wgid % NXCD, off = wgid / NXCD; wgid = (xcd < r ? xcd * (q + 1) : r * (q + 1) + (xcd - r) * q) + off; }
        const int nig = WGM * nN, gid = wgid / nig, fm = gid * WGM, gsz = (nM - fm) < WGM ? (nM - fm) : WGM;
        u.pm = fm + ((wgid % nig) % gsz); u.pn = (wgid % nig) / gsz; return true;
    }
    __device__ __forceinline__ void a_ready(const Unit&) const {}
    __device__ __forceinline__ void done(const Unit&) const {}
};

#define PG8_GAS __attribute__((address_space(1)))
constexpr int XROW0 = 8192, MROWS = 8704;
__device__ __forceinline__ float row_rstd(const PG8_GAS float* ssq, int row, int fq) {
    const PG8_GAS f32x4* p0 = (const PG8_GAS f32x4*)(ssq + ((size_t)(2 * fq) * MROWS + row) * 8); const PG8_GAS f32x4* p1 = (const PG8_GAS f32x4*)(ssq + ((size_t)(2 * fq + 1) * MROWS + row) * 8);
    const f32x4 a = p0[0], b = p0[1], c = p1[0], d = p1[1];
    float s = (((a[0] + a[1]) + (a[2] + a[3])) + ((b[0] + b[1]) + (b[2] + b[3]))) + (((c[0] + c[1]) + (c[2] + c[3])) + ((d[0] + d[1]) + (d[2] + d[3])));
    s += __shfl_xor(s, 16); s += __shfl_xor(s, 32);
    return 1.0f / sqrtf(s * (1.0f / 2048.0f) + 1e-6f);
}
__device__ __forceinline__ float row_rstd_main(const PG8_GAS float* ssq, int row, int fq) {
    const f32x4 a = *(const PG8_GAS f32x4*)(ssq + ((size_t)(2 * fq) * MROWS + row) * 8), c = *(const PG8_GAS f32x4*)(ssq + ((size_t)(2 * fq + 1) * MROWS + row) * 8);
    float s = ((a[0] + a[1]) + (a[2] + a[3])) + ((c[0] + c[1]) + (c[2] + c[3]));
    s += __shfl_xor(s, 16); s += __shfl_xor(s, 32);
    return 1.0f / sqrtf(s * (1.0f / 2048.0f) + 1e-6f);
}
__device__ __forceinline__ unsigned cvt_pk_bf16(float lo, float hi) { unsigned r; asm volatile("v_cvt_pk_bf16_f32 %0, %1, %2" : "=v"(r) : "v"(lo), "v"(hi)); return r; }

struct EpiProj {
    static constexpr bool PERM = true;
    PG8_GAS bf16_t* O; PG8_GAS float* AB; const PG8_GAS float* ssq;
    __device__ __forceinline__ void operator()(const f32x4 (&acc)[2][2][4][2], const Unit& u, int wr, int wc, int fr, int fq) const {
        const int row0 = u.pm * BM + wr * 64 + fr;
        float rsv[2][4];
#pragma unroll
        for (int ai = 0; ai < 2; ++ai)
#pragma unroll
            for (int m = 0; m < 4; ++m) rsv[ai][m] = (u.pm < XROW0 / BM) ? row_rstd_main(ssq, row0 + ai * HALF + m * 16, fq) : row_rstd(ssq, row0 + ai * HALF + m * 16, fq);
        if (u.pn < 28) {
            const int col0 = u.pn * BM + wc * 32 + 8 * fq;
#pragma unroll
            for (int ai = 0; ai < 2; ++ai)
#pragma unroll
                for (int m = 0; m < 4; ++m) { const int row = row0 + ai * HALF + m * 16; const float rs = rsv[ai][m]; PG8_GAS bf16_t* rowp = O + (size_t)row * 7168 + col0;
#pragma unroll
                    for (int bj = 0; bj < 2; ++bj) { const f32x4 v0 = acc[ai][bj][m][0] * rs, v1 = acc[ai][bj][m][1] * rs;
                        u32x4 w; w.x = cvt_pk_bf16(v0[0], v0[1]); w.y = cvt_pk_bf16(v0[2], v0[3]); w.z = cvt_pk_bf16(v1[0], v1[1]); w.w = cvt_pk_bf16(v1[2], v1[3]);
                        *(PG8_GAS u32x4*)(rowp + bj * HALF) = w; } }
        } else if (wc == 0) {
#pragma unroll
            for (int ai = 0; ai < 2; ++ai)
#pragma unroll
                for (int m = 0; m < 4; ++m) { const int row = row0 + ai * HALF + m * 16; const float rs = rsv[ai][m]; PG8_GAS float* rowp = AB + (size_t)row * 16 + 8 * (fq & 1);
                    if (fq < 2) { *(PG8_GAS f32x4*)(rowp) = acc[ai][0][m][0] * rs; *(PG8_GAS f32x4*)(rowp + 4) = acc[ai][0][m][1] * rs; } }
        }
    }
    __device__ __forceinline__ void extra(const f32x4 (&accx)[2], const Unit& u, int wr, int wc, int fr, int fq) const {
        const int row = XROW0 + u.pm * 16 + fr;
        if (u.pn < 28) {
            const float rs = row_rstd(ssq, row, fq); const f32x4 v0 = accx[0] * rs, v1 = accx[1] * rs;
            u32x4 w; w.x = cvt_pk_bf16(v0[0], v0[1]); w.y = cvt_pk_bf16(v0[2], v0[3]); w.z = cvt_pk_bf16(v1[0], v1[1]); w.w = cvt_pk_bf16(v1[2], v1[3]);
            *(PG8_GAS u32x4*)(O + (size_t)row * 7168 + u.pn * BM + wr * HALF + wc * 32 + 8 * fq) = w;
        } else if (wr == 0 && wc == 0) {
            const float rs = row_rstd(ssq, row, fq); PG8_GAS float* rowp = AB + (size_t)row * 16 + 8 * (fq & 1);
            if (fq < 2) { *(PG8_GAS f32x4*)(rowp) = accx[0] * rs; *(PG8_GAS f32x4*)(rowp + 4) = accx[1] * rs; }
        }
    }
};
struct EpiRes {
    static constexpr bool PERM = true;
    PG8_GAS bf16_t* XB; PG8_GAS float* ssq; int ldc; float sc; PG8_GAS float* XF;
    static __device__ __forceinline__ f32x4 lo4(const u32x4 v) { return (f32x4){__builtin_bit_cast(float, v.x << 16), __builtin_bit_cast(float, v.x & 0xffff0000u), __builtin_bit_cast(float, v.y << 16), __builtin_bit_cast(float, v.y & 0xffff0000u)}; }
    static __device__ __forceinline__ f32x4 hi4(const u32x4 v) { return (f32x4){__builtin_bit_cast(float, v.z << 16), __builtin_bit_cast(float, v.z & 0xffff0000u), __builtin_bit_cast(float, v.w << 16), __builtin_bit_cast(float, v.w & 0xffff0000u)}; }
    __device__ __forceinline__ void operator()(const f32x4 (&acc)[2][2][4][2], const Unit& u, int wr, int wc, int fr, int fq) const {
        const int row0 = u.pm * BM + wr * 64 + fr, col0 = u.pn * BM + wc * 32 + 8 * fq;
#pragma unroll
        for (int ai = 0; ai < 2; ++ai) {
            u32x4 v[4][2];
#pragma unroll
            for (int m = 0; m < 4; ++m) { const PG8_GAS bf16_t* rowb = XB + (size_t)(row0 + ai * HALF + m * 16) * ldc + col0;
#pragma unroll
                for (int bj = 0; bj < 2; ++bj) v[m][bj] = *(const PG8_GAS u32x4*)(rowb + bj * HALF); }
#pragma unroll
            for (int m = 0; m < 4; ++m) { const int row = row0 + ai * HALF + m * 16; PG8_GAS bf16_t* rowb = XB + (size_t)row * ldc + col0; float ss = 0.f;
#pragma unroll
                for (int bj = 0; bj < 2; ++bj) { const f32x4 x0 = lo4(v[m][bj]) + acc[ai][bj][m][0] * sc, x1 = hi4(v[m][bj]) + acc[ai][bj][m][1] * sc;
                    u32x4 w; w.x = cvt_pk_bf16(x0[0], x0[1]); w.y = cvt_pk_bf16(x0[2], x0[3]); w.z = cvt_pk_bf16(x1[0], x1[1]); w.w = cvt_pk_bf16(x1[2], x1[3]);
                    *(PG8_GAS u32x4*)(rowb + bj * HALF) = w;
                    if (XF) { PG8_GAS float* rowf = XF + (size_t)row * ldc + col0 + bj * HALF; *(PG8_GAS f32x4*)rowf = x0; *(PG8_GAS f32x4*)(rowf + 4) = x1; }
                    ss += ((x0[0] * x0[0] + x0[1] * x0[1]) + (x0[2] * x0[2] + x0[3] * x0[3])) + ((x1[0] * x1[0] + x1[1] * x1[1]) + (x1[2] * x1[2] + x1[3] * x1[3])); }
                ss += __shfl_xor(ss, 16); ss += __shfl_xor(ss, 32);
                if (fq == 0) ssq[((size_t)u.pn * MROWS + row) * 8 + wc] = ss; }
            asm volatile("" ::: "memory");
        }
    }
    __device__ __forceinline__ void extra(const f32x4 (&accx)[2], const Unit& u, int wr, int wc, int fr, int fq) const {
        const int row = XROW0 + u.pm * 16 + fr, col0 = u.pn * BM + wr * HALF + wc * 32 + 8 * fq;
        PG8_GAS bf16_t* rowb = XB + (size_t)row * ldc + col0;
        const u32x4 v = *(const PG8_GAS u32x4*)rowb;
        const f32x4 x0 = lo4(v) + accx[0] * sc, x1 = hi4(v) + accx[1] * sc;
        u32x4 w; w.x = cvt_pk_bf16(x0[0], x0[1]); w.y = cvt_pk_bf16(x0[2], x0[3]); w.z = cvt_pk_bf16(x1[0], x1[1]); w.w = cvt_pk_bf16(x1[2], x1[3]);
        *(PG8_GAS u32x4*)rowb = w;
        if (XF) { PG8_GAS float* rowf = XF + (size_t)row * ldc + col0; *(PG8_GAS f32x4*)rowf = x0; *(PG8_GAS f32x4*)(rowf + 4) = x1; }
        float ss = ((x0[0] * x0[0] + x0[1] * x0[1]) + (x0[2] * x0[2] + x0[3] * x0[3])) + ((x1[0] * x1[0] + x1[1] * x1[1]) + (x1[2] * x1[2] + x1[3] * x1[3]));
        ss += __shfl_xor(ss, 16); ss += __shfl_xor(ss, 32);
        if (fq == 0) ssq[((size_t)u.pn * MROWS + row) * 8 + 4 * wr + wc] = ss;
    }
};
struct EpiUp {
    static constexpr bool PERM = true;
    PG8_GAS bf16_t* O; int ldc; const PG8_GAS float* ssq;
    __device__ __forceinline__ void operator()(const f32x4 (&acc)[2][2][4][2], const Unit& u, int wr, int wc, int fr, int fq) const {
        const int row0 = u.pm * BM + wr * 64 + fr, col0 = u.pn * BM + wc * 32 + 8 * fq;
        float rsv[2][4];
#pragma unroll
        for (int ai = 0; ai < 2; ++ai)
#pragma unroll
            for (int m = 0; m < 4; ++m) rsv[ai][m] = row_rstd_main(ssq, row0 + ai * HALF + m * 16, fq);
#pragma unroll
        for (int ai = 0; ai < 2; ++ai)
#pragma unroll
            for (int m = 0; m < 4; ++m) { const int row = row0 + ai * HALF + m * 16; const float rs = rsv[ai][m]; PG8_GAS bf16_t* rowp = O + (size_t)row * ldc + col0;
#pragma unroll
                for (int bj = 0; bj < 2; ++bj) { f32x4 v0 = acc[ai][bj][m][0] * rs, v1 = acc[ai][bj][m][1] * rs;
#pragma unroll
                    for (int j = 0; j < 4; ++j) { const float a = v0[j] > 0.f ? v0[j] : 0.f, b = v1[j] > 0.f ? v1[j] : 0.f; v0[j] = a * a; v1[j] = b * b; }
                    u32x4 w; w.x = cvt_pk_bf16(v0[0], v0[1]); w.y = cvt_pk_bf16(v0[2], v0[3]); w.z = cvt_pk_bf16(v1[0], v1[1]); w.w = cvt_pk_bf16(v1[2], v1[3]);
                    *(PG8_GAS u32x4*)(rowp + bj * HALF) = w; } }
    }
    __device__ __forceinline__ void extra(const f32x4 (&accx)[2], const Unit& u, int wr, int wc, int fr, int fq) const {
        const int row = XROW0 + u.pm * 16 + fr; const float rs = row_rstd(ssq, row, fq); f32x4 v0 = accx[0] * rs, v1 = accx[1] * rs;
#pragma unroll
        for (int j = 0; j < 4; ++j) { const float a = v0[j] > 0.f ? v0[j] : 0.f, b = v1[j] > 0.f ? v1[j] : 0.f; v0[j] = a * a; v1[j] = b * b; }
        u32x4 w; w.x = cvt_pk_bf16(v0[0], v0[1]); w.y = cvt_pk_bf16(v0[2], v0[3]); w.z = cvt_pk_bf16(v1[0], v1[1]); w.w = cvt_pk_bf16(v1[2], v1[3]);
        *(PG8_GAS u32x4*)(O + (size_t)row * ldc + u.pn * BM + wr * HALF + wc * 32 + 8 * fq) = w;
    }
};
template <class Epi, class Sched, bool ALIGN_EPI = false, bool SP2 = false, bool XR = true>
__device__ __forceinline__ void gemm_phase(PG8_LAS unsigned char* lds, const Gemm g, const Sched& S, const Epi& E) {
    const int tid = opaque_tid(), wid = __builtin_amdgcn_readfirstlane(tid >> 6), lane = tid & 63, wr = wid >> 2, wc = wid & 3, fr = lane & 15, fq = lane >> 4;
    const int K = g.K, nt = K / BK;
    unsigned voffA[2], voffB[2];
#pragma unroll
    for (int i = 0; i < 2; ++i) { int R, C; stage_rc(tid * 16 + i * 8192, R, C); const int Rb = Epi::PERM ? ((R & ~31) + perm32(R & 31)) : R;
        voffA[i] = (unsigned)(R * K + C) * 2u; voffB[i] = (unsigned)(Rb * K + C) * 2u; }
    const size_t kstep = (size_t)(BK * 2);
    const size_t hstep = (size_t)HALF * K * 2;
    const size_t tstep = 2 * hstep;
    const unsigned ldsw = (unsigned)wid * 1024u;
    const unsigned ldsb = (unsigned)(size_t)lds + ldsw;
    const int aoff = lds_byte(wr * 64 + fr, fq * 8), boff = lds_byte(wc * 32 + fr, fq * 8);
#define PG8_SA(b, h) (((b) * 2 + (h)) * HTB)
#define PG8_SB(b, h) ((4 + (b) * 2 + (h)) * HTB)
#define PG8_STAGE(bufoff, gbase, voff) do { _Pragma("unroll") for (int _i = 0; _i < 2; ++_i) { unsigned _keep; \
        asm volatile("s_mov_b32 %0, m0\n\ts_mov_b32 m0, %2\n\ts_nop 0\n\tglobal_load_lds_dwordx4 %1, %3\n\ts_mov_b32 m0, %0" : "=&s"(_keep) : "v"((voff)[_i]), "s"(ldsb + (unsigned)((bufoff) + _i * 8192)), "s"(gbase) : "memory"); } } while (0)
#define PG8_LDA(dst, b, h) do { _Pragma("unroll") for (int m = 0; m < 4; ++m) _Pragma("unroll") for (int k = 0; k < 2; ++k) dst[m][k] = *(const PG8_LAS bf16x8*)(lds + PG8_SA(b, h) + aoff + m * 2048 + k * 1024); } while (0)
#define PG8_LDB(dst, b, h) do { _Pragma("unroll") for (int n = 0; n < 2; ++n) _Pragma("unroll") for (int k = 0; k < 2; ++k) dst[n][k] = *(const PG8_LAS bf16x8*)(lds + PG8_SB(b, h) + boff + n * 2048 + k * 1024); } while (0)
#define PG8_MMA(ai, bj, At, Bt) do { __builtin_amdgcn_s_setprio(1); _Pragma("unroll") for (int m = 0; m < 4; ++m) _Pragma("unroll") for (int n = 0; n < 2; ++n) _Pragma("unroll") for (int k = 0; k < 2; ++k) \
        acc[ai][bj][m][n] = __builtin_amdgcn_mfma_f32_16x16x32_bf16(Bt[n][k], At[m][k], acc[ai][bj][m][n], 0, 0, 0); __builtin_amdgcn_s_setprio(0); } while (0)
#define PG8_WAIT_V(n) asm volatile("s_waitcnt vmcnt(" #n ")" ::: "memory")
#define PG8_WAIT_L(n) asm volatile("s_waitcnt lgkmcnt(" #n ")" ::: "memory")
#define PG8_BAR __builtin_amdgcn_s_barrier()
#define PG8_SCHED __builtin_amdgcn_sched_barrier(0)
    Unit cur, nxt; int ui = 0;
    if (!S.next(0, cur)) return;
    f32x4 acc[2][2][4][2];
#pragma unroll
    for (int a = 0; a < 2; ++a)
#pragma unroll
        for (int b = 0; b < 2; ++b)
#pragma unroll
            for (int m = 0; m < 4; ++m)
#pragma unroll
                for (int n = 0; n < 2; ++n) acc[a][b][m][n] = (f32x4){0.f, 0.f, 0.f, 0.f};
    bf16x8 At[4][2], B0[2][2], B1[2][2];
    const char* cA = (const char*)g.A + (size_t)cur.pm * tstep; const char* cB = (const char*)g.Bt + (size_t)cur.pn * tstep;
    S.a_ready(cur);
    const unsigned voffX = (unsigned)(fr * K + fq * 8) * 2u;
    const size_t xstep = (size_t)16 * K * 2;
    const char* xA = (const char*)g.Ax + (size_t)cur.pm * xstep + (wid & 1) * 64;
    const unsigned xring = (unsigned)(size_t)lds + STAGE_BYTES + (wid & 1) * 1024;
    const int xoff = STAGE_BYTES + lane * 16;
    f32x4 accx[2] = {(f32x4){0.f, 0.f, 0.f, 0.f}, (f32x4){0.f, 0.f, 0.f, 0.f}}; bf16x8 Xf[2];
#define PG8_STAGEX(slot, base) do { if (XR && wid < 2) { unsigned _keep; asm volatile("s_mov_b32 %0, m0\n\ts_mov_b32 m0, %2\n\ts_nop 0\n\tglobal_load_lds_dwordx4 %1, %3\n\ts_mov_b32 m0, %0" : "=&s"(_keep) : "v"(voffX), "s"(xring + (unsigned)(slot) * 2048u), "s"(base) : "memory"); } } while (0)
#define PG8_LDX(slot) do { if constexpr (XR) { Xf[0] = *(const PG8_LAS bf16x8*)(lds + xoff + (slot) * 2048); Xf[1] = *(const PG8_LAS bf16x8*)(lds + xoff + (slot) * 2048 + 1024); } } while (0)
#define PG8_WAIT_V89() do { if (XR && wid < 2) PG8_WAIT_V(9); else PG8_WAIT_V(8); } while (0)
#define PG8_MMAX() do { if constexpr (XR) { if (wr == 0) { accx[0] = __builtin_amdgcn_mfma_f32_16x16x32_bf16(B0[0][0], Xf[0], accx[0], 0, 0, 0); accx[1] = __builtin_amdgcn_mfma_f32_16x16x32_bf16(B0[1][0], Xf[0], accx[1], 0, 0, 0); \
                                       accx[0] = __builtin_amdgcn_mfma_f32_16x16x32_bf16(B0[0][1], Xf[1], accx[0], 0, 0, 0); accx[1] = __builtin_amdgcn_mfma_f32_16x16x32_bf16(B0[1][1], Xf[1], accx[1], 0, 0, 0); } \
                         else         { accx[0] = __builtin_amdgcn_mfma_f32_16x16x32_bf16(B1[0][0], Xf[0], accx[0], 0, 0, 0); accx[1] = __builtin_amdgcn_mfma_f32_16x16x32_bf16(B1[1][0], Xf[0], accx[1], 0, 0, 0); \
                                       accx[0] = __builtin_amdgcn_mfma_f32_16x16x32_bf16(B1[0][1], Xf[1], accx[0], 0, 0, 0); accx[1] = __builtin_amdgcn_mfma_f32_16x16x32_bf16(B1[1][1], Xf[1], accx[1], 0, 0, 0); } } } while (0)
    PG8_STAGEX(0, xA); PG8_STAGEX(1, xA + kstep);
    {
        PG8_STAGE(PG8_SB(0, 0), cB, voffB); PG8_STAGE(PG8_SB(0, 1), cB + hstep, voffB); PG8_STAGE(PG8_SA(0, 0), cA, voffA); PG8_STAGE(PG8_SA(0, 1), cA + hstep, voffA);
        if (wr == 1) PG8_BAR;
        PG8_WAIT_V(2); PG8_BAR;
        PG8_STAGE(PG8_SB(1, 0), cB + kstep, voffB); PG8_STAGE(PG8_SA(1, 0), cA + kstep, voffA); PG8_STAGE(PG8_SB(1, 1), cB + hstep + kstep, voffB);
        PG8_WAIT_V(6); PG8_BAR;
    }
    for (;;) {
        const bool has_next = S.next(ui + 1, nxt);
        const char* nA = has_next ? (const char*)g.A + (size_t)nxt.pm * tstep : cA; const char* nB = has_next ? (const char*)g.Bt + (size_t)nxt.pn * tstep : cB;
        const char* nxA = has_next ? (const char*)g.Ax + (size_t)nxt.pm * xstep + (wid & 1) * 64 : xA;
        for (int t = 0; t < nt; t += 2) {
            const bool last = (t == nt - 2);
            const char* a1 = cA + (size_t)(t + 1) * kstep;
            const char* a2 = last ? nA : cA + (size_t)(t + 2) * kstep; const char* b2 = last ? nB : cB + (size_t)(t + 2) * kstep;
            const char* a3 = a2 + kstep; const char* b3 = b2 + kstep;
            if (last && has_next) S.a_ready(nxt);
            const char* x2 = last ? nxA : xA + (size_t)(t + 2) * kstep;
            const int s0 = t & 2;
            PG8_LDB(B0, 0, 0); PG8_LDB(B1, 0, 1); PG8_SCHED; PG8_LDA(At, 0, 0); PG8_LDX(s0); PG8_STAGE(PG8_SA(1, 1), a1 + hstep, voffA); PG8_STAGEX(s0 ^ 2, x2);
            PG8_WAIT_V89(); PG8_WAIT_L(0); PG8_BAR; PG8_MMA(0, 0, At, B0); PG8_MMA(0, 1, At, B1); PG8_MMAX(); PG8_BAR; PG8_SCHED;
            PG8_LDA(At, 0, 1); PG8_STAGE(PG8_SB(0, 0), b2, voffB); PG8_STAGE(PG8_SB(0, 1), b2 + hstep, voffB); PG8_STAGE(PG8_SA(0, 0), a2, voffA);
            PG8_WAIT_V89(); PG8_WAIT_L(0); PG8_BAR; PG8_MMA(1, 0, At, B0); PG8_MMA(1, 1, At, B1); PG8_BAR; PG8_SCHED;
            PG8_LDB(B0, 1, 0); PG8_LDB(B1, 1, 1); PG8_SCHED; PG8_LDA(At, 1, 0); PG8_LDX(s0 + 1); PG8_STAGE(PG8_SA(0, 1), a2 + hstep, voffA); PG8_STAGEX((s0 ^ 2) + 1, x2 + kstep);
            PG8_WAIT_V89(); PG8_WAIT_L(0); PG8_BAR; PG8_MMA(0, 0, At, B0); PG8_MMA(0, 1, At, B1); PG8_MMAX(); PG8_BAR; PG8_SCHED;
            PG8_LDA(At, 1, 1); PG8_STAGE(PG8_SB(1, 0), b3, voffB); PG8_STAGE(PG8_SB(1, 1), b3 + hstep, voffB); PG8_STAGE(PG8_SA(1, 0), a3, voffA);
            PG8_WAIT_V89(); PG8_WAIT_L(0); PG8_BAR; PG8_MMA(1, 0, At, B0); PG8_MMA(1, 1, At, B1); PG8_BAR; PG8_SCHED;
        }
        if constexpr (ALIGN_EPI) { if (wr == 0) PG8_BAR; }
        { int fr_ = fr, fq_ = fq; asm volatile("" : "+v"(fr_), "+v"(fq_));
          E(acc, cur, wr, wc, fr_, fq_); if constexpr (XR) E.extra(accx, cur, wr, wc, fr_, fq_); S.done(cur); }
        if (!has_next) break;
#pragma unroll
        for (int a = 0; a < 2; ++a)
#pragma unroll
            for (int b = 0; b < 2; ++b)
#pragma unroll
                for (int m = 0; m < 4; ++m)
#pragma unroll
                    for (int n = 0; n < 2; ++n) acc[a][b][m][n] = (f32x4){0.f, 0.f, 0.f, 0.f};
        accx[0] = (f32x4){0.f, 0.f, 0.f, 0.f}; accx[1] = accx[0];
        cur = nxt; cA = nA; cB = nB; xA = nxA; ++ui;
        if constexpr (ALIGN_EPI) { if (wr == 1) PG8_BAR; }
    }
    PG8_WAIT_V(0);
    if constexpr (!ALIGN_EPI) { if (wr == 0) PG8_BAR; }
    PG8_BAR;
#undef PG8_SA
#undef PG8_SB
#undef PG8_STAGE
#undef PG8_LDA
#undef PG8_LDB
#undef PG8_MMA
#undef PG8_WAIT_V
#undef PG8_WAIT_L
#undef PG8_BAR
#undef PG8_SCHED
#undef PG8_STAGEX
#undef PG8_LDX
#undef PG8_WAIT_V89
#undef PG8_MMAX
}
}
#define XB_TMO      128
#define XB_XCNT(j)  (256  + 64 * (j))
#define XB_XSUB(j)  (1280 + 64 * (j))
#define XB_XGEN(j)  (2304 + 64 * (j))
#define XB_TOP      3328
#define XB_TOPGEN   3392
#define XCD_BAR_WORDS 3456
#define XB_SPIN_CAP (1u << 18)

__device__ __forceinline__ unsigned xb_ld(unsigned* p)              { return __hip_atomic_load(p, __ATOMIC_RELAXED, __HIP_MEMORY_SCOPE_AGENT); }
__device__ __forceinline__ unsigned xb_add(unsigned* p, unsigned v) { return __hip_atomic_fetch_add(p, v, __ATOMIC_RELAXED, __HIP_MEMORY_SCOPE_AGENT); }
__device__ __forceinline__ unsigned xb_xcc_id() { return (unsigned)__builtin_amdgcn_s_getreg((3 << 11) | 20) & 0xFu; }
#define XB_SPIN(cond, bar) do { unsigned _sp = 0; while (cond) { __builtin_amdgcn_s_sleep(1); \
    if ((++_sp & 255u) == 0u) { if (xb_ld(&(bar)[XB_TMO])) break; if (_sp > XB_SPIN_CAP) { atomicAdd(&(bar)[XB_TMO], 1u); break; } } } } while (0)

struct XcdBarrier {
    unsigned* bar; unsigned x;
    volatile LAS unsigned* st;
};

__device__ __forceinline__ XcdBarrier xcd_barrier_post(unsigned* bar, volatile LAS unsigned* st) {
    XcdBarrier b; b.bar = bar; b.x = xb_xcc_id(); b.st = st;
    if (threadIdx.x == 0) (void)xb_add(&bar[XB_XCNT(b.x)], 1u);
    return b;
}
__device__ __forceinline__ void xcd_barrier_complete(unsigned* bar, unsigned x, unsigned& nloc, unsigned& nx) {
    const unsigned G = gridDim.x * gridDim.y * gridDim.z;
    unsigned sum, cnt, mine, sp = 0u;
    for (;;) {
        sum = 0u; cnt = 0u; mine = 0u;
#pragma unroll
        for (unsigned j = 0; j < 16; ++j) { const unsigned c = xb_ld(&bar[XB_XCNT(j)]); sum += c; cnt += (c > 0u) ? 1u : 0u; mine = (j == x) ? c : mine; }
        if (sum == G) break;
        __builtin_amdgcn_s_sleep(1);
        if ((++sp & 255u) == 0u) { if (xb_ld(&bar[XB_TMO])) break; if (sp > XB_SPIN_CAP) { atomicAdd(&bar[XB_TMO], 1u); break; } }
    }
    nloc = mine > 0u ? mine : 1u; nx = cnt > 0u ? cnt : 1u;
}

__device__ __forceinline__ void xcd_barrier(const XcdBarrier& b) {
    asm volatile("s_waitcnt vmcnt(0)" ::: "memory");
    __syncthreads();
    if (threadIdx.x == 0) {
        unsigned* bar = b.bar;
        __builtin_amdgcn_s_waitcnt(0);
        unsigned nloc = b.st[0], nx = b.st[1];
        if (nloc == 0u) { xcd_barrier_complete(bar, b.x, nloc, nx); b.st[0] = nloc; b.st[1] = nx; }
        const unsigned old = xb_add(&bar[XB_XSUB(b.x)], 1u);
        const unsigned gen = old / nloc;
        if (old + 1u == (gen + 1u) * nloc) {
            __builtin_amdgcn_fence(__ATOMIC_RELEASE, "agent");
            asm volatile("s_waitcnt vmcnt(0)" ::: "memory");
            const unsigned og = xb_add(&bar[XB_TOP], 1u);
            const unsigned tg = og / nx;
            if (og + 1u == (tg + 1u) * nx) xb_add(&bar[XB_TOPGEN], 1u);
            else XB_SPIN(xb_ld(&bar[XB_TOPGEN]) == tg, bar);
            __builtin_amdgcn_fence(__ATOMIC_ACQUIRE, "agent");
            xb_add(&bar[XB_XGEN(b.x)], 1u);
            asm volatile("s_waitcnt vmcnt(0)" ::: "memory");
        } else {
            XB_SPIN(xb_ld(&bar[XB_XGEN(b.x)]) == gen, bar);
            __builtin_amdgcn_fence(__ATOMIC_ACQUIRE, "agent");
            asm volatile("s_waitcnt vmcnt(0)" ::: "memory");
        }
    }
    __syncthreads();
}
#endif
typedef GAS float gf32; typedef GAS bf16 gbf16; typedef GAS unsigned char gu8; typedef GAS f32x4 gf32x4; typedef GAS u32x4 gu32x4; typedef GAS u32x2 gu32x2;
typedef LAS float lf32; typedef LAS bf16 lbf16; typedef LAS unsigned char lu8; typedef LAS f32x4 lf32x4; typedef LAS u32x4 lu32x4; typedef LAS u32x2 lu32x2; typedef LAS bf16x8 lbf16x8;
struct P {
    const gf32 *x_prompt, *x_sample, *st_conv_a, *st_conv_qkv, *st_delta, *norm_mix_w, *w_in, *conv_a_w, *conv_a_norm_w, *conv_qkv_w, *a_log, *dt_bias, *dn_norm_w, *w_out, *norm_ffn_w, *w_up, *w_down, *final_norm_w;
    gf32* out; gu8* ws;
    gf32* X; gbf16* XB; gf32* SSQ; gbf16* PROJ; gf32* AB; gbf16* MIX; gbf16* UP; gu8* MXB; gbf16* ORAW; gf32* PSS;
};
DI float wave_sum(float v) {
#pragma unroll
    for (int o = 1; o < 64; o <<= 1) v += shfl_xor_f(v, o);
    return v;
}
DI bf16x8 frag2(const lbf16* base, int off0, int off1) {
    const u32x2 lo = *(const lu32x2*)(base + off0), hi = *(const lu32x2*)(base + off1);
    u32x4 w; w.x = lo.x; w.y = lo.y; w.z = hi.x; w.w = hi.y; return __builtin_bit_cast(bf16x8, w);
}
DI bf16x8 pack8(const f32x4& a, const f32x4& b) { u32x4 w; w.x = pk2(a[0], a[1]); w.y = pk2(a[2], a[3]); w.z = pk2(b[0], b[1]); w.w = pk2(b[2], b[3]); return __builtin_bit_cast(bf16x8, w); }

constexpr int TS = 65;
DI void transpose64(const gf32* W, int ldw, int ncv, int K, gbf16* WT, const gf32* scale, lf32* scr, int kb, int nb, int lane) {
    const int k0 = 64 * kb, n0 = 64 * nb, kr = lane >> 4, n4 = 4 * (lane & 15); const bool ok = (n0 + n4) < ncv;
    f32x4 v[16];
#pragma unroll
    for (int i = 0; i < 16; ++i) v[i] = ok ? __builtin_nontemporal_load((const gf32x4*)(W + (size_t)(k0 + 4 * i + kr) * ldw + n0 + n4)) : (f32x4){0.f, 0.f, 0.f, 0.f};
#pragma unroll
    for (int i = 0; i < 16; ++i) { const int k = 4 * i + kr; const float s = scale ? scale[k0 + k] : 1.0f;
        scr[k * TS + n4] = v[i][0] * s; scr[k * TS + n4 + 1] = v[i][1] * s; scr[k * TS + n4 + 2] = v[i][2] * s; scr[k * TS + n4 + 3] = v[i][3] * s; }
    WAVE_FENCE();
    const int kc = lane & 7;
#pragma unroll
    for (int j = 0; j < 8; ++j) { const int n = (lane >> 3) + 8 * j; const lf32* s = scr + (8 * kc) * TS + n;
        u32x4 o; o.x = pk2(s[0], s[TS]); o.y = pk2(s[2 * TS], s[3 * TS]); o.z = pk2(s[4 * TS], s[5 * TS]); o.w = pk2(s[6 * TS], s[7 * TS]);
        if (n0 + n < ncv) __builtin_nontemporal_store(o, (gu32x4*)(WT + (size_t)(n0 + n) * K + k0 + 8 * kc)); }
    WAVE_FENCE();
}
#ifdef NO_OVERLAP_CONV
constexpr bool CONV_IN_MX2 = false;
#else
constexpr bool CONV_IN_MX2 = true;
#endif
constexpr int IT_IN = 32 * 113, IT_OUT = 32 * 32, IT_UP = 32 * 128, IT_DOWN = 128 * 32, IT_LAYER = IT_IN + IT_OUT + IT_UP + IT_DOWN;
constexpr int CONV_SPLIT = 8800;
DI void convert_layer(const P& p, int l, lu8* lds, int wi, int nw, int wave, int lane, int it0 = 0, int it1 = IT_LAYER) {
    lf32* scr = (lf32*)(lds + wave * 16640);
    gu8* wl = p.ws + WS_W + (size_t)l * WL_BYTES;
    for (int it = it0 + wi; it < it1; it += nw) {
        int r = it;
        if (r < IT_IN) { transpose64(p.w_in + (size_t)l * D * DIN, DIN, DIN, D, (gbf16*)(wl + WL_IN), p.norm_mix_w + l * D, scr, r / 113, r % 113, lane); continue; } r -= IT_IN;
        if (r < IT_OUT) { transpose64(p.w_out + (size_t)l * D * D, D, D, D, (gbf16*)(wl + WL_OUT), nullptr, scr, r / 32, r % 32, lane); continue; } r -= IT_OUT;
        if (r < IT_UP) { transpose64(p.w_up + (size_t)l * D * DFF, DFF, DFF, D, (gbf16*)(wl + WL_UP), p.norm_ffn_w + l * D, scr, r / 128, r % 128, lane); continue; } r -= IT_UP;
        transpose64(p.w_down + (size_t)l * DFF * D, D, D, DFF, (gbf16*)(wl + WL_DOWN), nullptr, scr, r / 32, r % 32, lane);
    }
}
DI void p0_prologue(const P& p, lu8* lds) {
    const int tid = TID, lane = tid & 63, wave = WAVE_OF(tid), gw = BID * NWAVES + wave, ngw = GRID * NWAVES;
#ifdef NO_OVERLAP_CONV
    for (int l = 0; l < DEPTH; ++l) convert_layer(p, l, lds, gw, ngw, wave, lane);
#else
    convert_layer(p, 0, lds, gw, ngw, wave, lane);
#endif
    for (int m = gw; m < M; m += ngw) {
        const gf32x4* xr = (const gf32x4*)(m < MP ? p.x_prompt + (size_t)m * D : p.x_sample + (size_t)(m - MP) * D) + lane; f32x4 v[8]; float s = 0.f;
#pragma unroll
        for (int j = 0; j < 8; ++j) { v[j] = xr[64 * j]; s += (v[j][0] * v[j][0] + v[j][1] * v[j][1]) + (v[j][2] * v[j][2] + v[j][3] * v[j][3]); }
        s = wave_sum(s);
        gu32x2* o = (gu32x2*)(p.XB + (size_t)m * D) + lane;
#pragma unroll
        for (int j = 0; j < 8; ++j) { u32x2 w; w.x = pk2(v[j][0], v[j][1]); w.y = pk2(v[j][2], v[j][3]); o[64 * j] = w; }
        if (lane < 16) *(gf32x4*)(p.SSQ + ((size_t)(lane >> 1) * M + m) * 8 + (lane & 1) * 4) = (f32x4){lane == 0 ? s : 0.f, 0.f, 0.f, 0.f};
    }
}
DI void fin_phase(const P& p) {
    const int tid = TID, lane = tid & 63, gw = BID * NWAVES + WAVE_OF(tid), ngw = GRID * NWAVES;
    f32x4 g[8];
#pragma unroll
    for (int j = 0; j < 8; ++j) g[j] = ((const gf32x4*)p.final_norm_w)[64 * j + lane];
    for (int m = gw; m < M; m += ngw) {
        const gu32x2* xr = (const gu32x2*)(p.XB + (size_t)m * D) + lane; float s = 0.f;
        u32x2 xv[8];
#pragma unroll
        for (int j = 0; j < 8; ++j) xv[j] = xr[64 * j];
#pragma unroll
        for (int t = 0; t < 8; ++t) { const gf32x4* q = (const gf32x4*)(p.SSQ + (size_t)(2 * DEPTH) * SSQ_ARR + ((size_t)t * M + m) * 8); const f32x4 a = q[0]; s += (a[0] + a[1]) + (a[2] + a[3]); if (m >= MP) { const f32x4 c = q[1]; s += (c[0] + c[1]) + (c[2] + c[3]); } }
        const float r = rsqrt_f(s * (1.0f / D) + EPS);
        gf32x4* o = (gf32x4*)(p.out + O_Y + (size_t)m * D) + lane;
#pragma unroll
        for (int j = 0; j < 8; ++j) o[64 * j] = (f32x4){bflo(xv[j].x), bfhi(xv[j].x), bflo(xv[j].y), bfhi(xv[j].y)} * r * g[j];
    }
}

template <int NT>
DI void mx1_conva_item(const P& p, int l, int m0, int half, int lane, bool smp, int sb, bool first, gf32* dst) {
    const gf32* cw = p.conv_a_w + (size_t)l * 3 * DC; const gf32* nw = p.conv_a_norm_w + (size_t)l * DC;
    const int ch = 512 * half + 8 * lane;
    u32x4 cc[NT], hh[NT], bb[NT];
#pragma unroll
    for (int i = 0; i < NT; ++i) { const gbf16* r = p.PROJ + (size_t)(m0 + i) * NPJ + ch; cc[i] = *(const gu32x4*)(r + PC_C); hh[i] = *(const gu32x4*)(r + PC_H); bb[i] = *(const gu32x4*)(r + PC_B); }
    float w0[8], w1[8], w2[8], gn[8], u2[8], u1[8];
    if (smp) {
        const gf32* s0 = p.st_conv_a + ((size_t)(l * SB + sb) * 2) * DC + ch;
#pragma unroll
        for (int q = 0; q < 2; ++q) { const f32x4 a = *(const gf32x4*)(s0 + 4 * q), bq = *(const gf32x4*)(s0 + DC + 4 * q);
#pragma unroll
            for (int e = 0; e < 4; ++e) { u2[4 * q + e] = a[e]; u1[4 * q + e] = bq[e]; } }
    } else if (first) {
#pragma unroll
        for (int e = 0; e < 8; ++e) { u2[e] = 0.f; u1[e] = 0.f; }
    } else {
        const u32x4 c2 = *(const gu32x4*)(p.PROJ + (size_t)(m0 - 2) * NPJ + PC_C + ch), h2 = *(const gu32x4*)(p.PROJ + (size_t)(m0 - 2) * NPJ + PC_H + ch);
        const u32x4 c1 = *(const gu32x4*)(p.PROJ + (size_t)(m0 - 1) * NPJ + PC_C + ch), h1 = *(const gu32x4*)(p.PROJ + (size_t)(m0 - 1) * NPJ + PC_H + ch);
#pragma unroll
        for (int e = 0; e < 4; ++e) { u2[2 * e] = bflo(c2[e]) * bflo(h2[e]); u2[2 * e + 1] = bfhi(c2[e]) * bfhi(h2[e]); u1[2 * e] = bflo(c1[e]) * bflo(h1[e]); u1[2 * e + 1] = bfhi(c1[e]) * bfhi(h1[e]); }
    }
#pragma unroll
    for (int q = 0; q < 2; ++q) { const f32x4 a = *(const gf32x4*)(cw + ch + 4 * q), bq = *(const gf32x4*)(cw + DC + ch + 4 * q), c = *(const gf32x4*)(cw + 2 * DC + ch + 4 * q), d = *(const gf32x4*)(nw + ch + 4 * q);
#pragma unroll
        for (int e = 0; e < 4; ++e) { w0[4 * q + e] = a[e]; w1[4 * q + e] = bq[e]; w2[4 * q + e] = c[e]; gn[4 * q + e] = d[e]; } }
#pragma unroll
    for (int i = 0; i < NT; ++i) {
        float u0[8], y[8]; float ss = 0.f;
#pragma unroll
        for (int e = 0; e < 4; ++e) { u0[2 * e] = bflo(cc[i][e]) * bflo(hh[i][e]); u0[2 * e + 1] = bfhi(cc[i][e]) * bfhi(hh[i][e]); }
#pragma unroll
        for (int e = 0; e < 8; ++e) { const float bv = (e & 1) ? bfhi(bb[i][e >> 1]) : bflo(bb[i][e >> 1]); y[e] = bv * (w0[e] * u2[e] + w1[e] * u1[e] + w2[e] * u0[e]); ss += y[e] * y[e]; }
        ss = sum16_f(ss);
        const float rs = rsqrt_f(ss * (1.0f / CG) + EPS);
        u32x4 o;
#pragma unroll
        for (int e = 0; e < 4; ++e) o[e] = pk2(y[2 * e] * rs * gn[2 * e], y[2 * e + 1] * rs * gn[2 * e + 1]);
        *(gu32x4*)(p.MIX + (size_t)(m0 + i) * D + ch) = o;
#pragma unroll
        for (int e = 0; e < 8; ++e) { u2[e] = u1[e]; u1[e] = u0[e]; }
    }
    if (dst) {
        *(gf32x4*)(dst + ch) = (f32x4){u2[0], u2[1], u2[2], u2[3]}; *(gf32x4*)(dst + ch + 4) = (f32x4){u2[4], u2[5], u2[6], u2[7]};
        *(gf32x4*)(dst + DC + ch) = (f32x4){u1[0], u1[1], u1[2], u1[3]}; *(gf32x4*)(dst + DC + ch + 4) = (f32x4){u1[4], u1[5], u1[6], u1[7]};
    }
}
DI void mx1_conva_phase(const P& p, int l) {
    const int tid = TID, lane = tid & 63, wave = WAVE_OF(tid), gw = BID * NWAVES + wave, ngw = GRID * NWAVES;
    for (int wi = gw; wi < 2 * 1024; wi += ngw) { const int blk = wi >> 1, b = blk >> 8, t0 = (blk & 255) * 8;
        mx1_conva_item<8>(p, l, b * T + t0, wi & 1, lane, false, 0, t0 == 0, (t0 + 8 == T) ? p.out + O_CA_P + ((size_t)(l * NB + b) * 2) * DC : (gf32*)nullptr); }
    for (int si = BID + GRID * wave; si < 2 * SB; si += ngw) { const int sb = si >> 1;
        mx1_conva_item<4>(p, l, MP + 4 * sb, si & 1, lane, true, sb, false, p.out + O_CA_S + ((size_t)(l * SB + sb) * 2) * DC); }
}
DI void mx1_convstate_copy(const P& p, int l) {
    const int gtid = BID * (NWAVES * 64) + TID, nthr = GRID * NWAVES * 64;
    constexpr int NPQ = NB * 3 * 3072, NSQ = SB * 3 * 3072;
    for (int i = gtid; i < NPQ + NSQ; i += nthr) {
        if (i < NPQ) { const int b = i / 9216, r = i % 9216, ii = r / 3072, j = r % 3072;
            p.out[O_CQ_P + (size_t)l * NPQ + i] = bf2f(p.PROJ[(size_t)(b * T + T - 3 + ii) * NPJ + PC_QKV + j]); }
        else { const int k = i - NPQ, sb = k / 9216, r = k % 9216, ii = r / 3072, j = r % 3072;
            p.out[O_CQ_S + (size_t)l * NSQ + k] = bf2f(p.PROJ[(size_t)(MP + 4 * sb + 1 + ii) * NPJ + PC_QKV + j]); }
    }
}
constexpr int L1_AM = 0, L1_KF = 17408, L1_VF = 51200, L1_KB = 84992, L1_QB = 102400, L1_SM = 119808;
constexpr int FS = 132, BS = 136, AS = 68;
DI void mx1_chunk_item(const P& p, int l, int it, int itn, lu8* lds) {
    const int tid = TID, lane = tid & 63, w = WAVE_OF(tid);
    const int b = it >> 8, h = (it >> 5) & 7, n = it & 31;
    const int row0 = b * T + n * CH;
    lf32* AM = (lf32*)(lds + L1_AM); lf32* KF = (lf32*)(lds + L1_KF); lf32* VF = (lf32*)(lds + L1_VF);
    lbf16* KB = (lbf16*)(lds + L1_KB); lbf16* QB = (lbf16*)(lds + L1_QB); lf32* SM = (lf32*)(lds + L1_SM);
    lf32* sG = SM, *sBeta = SM + 64, *sEG = SM + 128, *sEGE = SM + 192;
    lbf16* WST = KB;
    gu8* rec = p.MXB + (size_t)it * CHB;
    const gf32* cw = p.conv_qkv_w + (size_t)l * 4 * 3072;
    if (tid < 64) {
        const float a = p.AB[(size_t)(row0 + tid) * 16 + h], bb = p.AB[(size_t)(row0 + tid) * 16 + 8 + h];
        float G = -EXPF(p.a_log[l * H + h]) * softplus_f(a + p.dt_bias[l * H + h]);
#pragma unroll
        for (int off = 1; off < 64; off <<= 1) { const float t = shfl_up_f(G, off); if (lane >= off) G += t; }
        sG[tid] = G; sBeta[tid] = sigmoid_f(bb); sEG[tid] = EXPF(G);
    }
    SYNC();
    if (tid < 64) sEGE[tid] = EXPF(sG[63] - sG[tid]);
    u32x4 rr[2][3][4];
#pragma unroll
    for (int i = 0; i < 2; ++i) {
        const int idx = tid + 512 * i, c = idx >> 4, d0 = 8 * (idx & 15);
        const bool z3 = (n == 0 && c < 3), z2 = (n == 0 && c < 2), z1 = (n == 0 && c < 1);
#pragma unroll
        for (int which = 0; which < 3; ++which) {
            const gbf16* src = p.PROJ + (size_t)(row0 + c) * NPJ + PC_QKV + which * 1024 + h * 128 + d0;
            rr[i][which][0] = *(const gu32x4*)src;
            rr[i][which][1] = z1 ? (u32x4){0u, 0u, 0u, 0u} : *(const gu32x4*)(src - (ptrdiff_t)NPJ);
            rr[i][which][2] = z2 ? (u32x4){0u, 0u, 0u, 0u} : *(const gu32x4*)(src - (ptrdiff_t)2 * NPJ);
            rr[i][which][3] = z3 ? (u32x4){0u, 0u, 0u, 0u} : *(const gu32x4*)(src - (ptrdiff_t)3 * NPJ);
        }
    }
#pragma unroll
    for (int i = 0; i < 2; ++i) {
        const int idx = tid + 512 * i, c = idx >> 4, d0 = 8 * (idx & 15);
#pragma unroll
        for (int which = 0; which < 3; ++which) {
            const int wcol = which * 1024 + h * 128 + d0;
            const u32x4 r0 = rr[i][which][0], r1 = rr[i][which][1], r2 = rr[i][which][2], r3 = rr[i][which][3];
            float o[8]; float ss = 0.f;
#pragma unroll
            for (int q = 0; q < 2; ++q) { const f32x4 w0 = *(const gf32x4*)(cw + wcol + 4 * q), w1 = *(const gf32x4*)(cw + 3072 + wcol + 4 * q), w2 = *(const gf32x4*)(cw + 2 * 3072 + wcol + 4 * q), w3 = *(const gf32x4*)(cw + 3 * 3072 + wcol + 4 * q);
#pragma unroll
                for (int e = 0; e < 4; ++e) { const int j = 4 * q + e; const unsigned a3 = r3[j >> 1], a2 = r2[j >> 1], a1 = r1[j >> 1], a0 = r0[j >> 1];
                    const float x3 = (j & 1) ? bfhi(a3) : bflo(a3), x2 = (j & 1) ? bfhi(a2) : bflo(a2), x1 = (j & 1) ? bfhi(a1) : bflo(a1), x0 = (j & 1) ? bfhi(a0) : bflo(a0);
                    o[j] = silu_f(w0[e] * x3 + w1[e] * x2 + w2[e] * x1 + w3[e] * x0); ss += o[j] * o[j]; } }
            if (which == 2) {
                *(lf32x4*)(VF + c * FS + d0) = (f32x4){o[0], o[1], o[2], o[3]}; *(lf32x4*)(VF + c * FS + d0 + 4) = (f32x4){o[4], o[5], o[6], o[7]};
            } else {
                ss = sum16_f(ss);
                const float sc = (which == 0 ? 0.08838834764831845f : 1.0f) * rsqrt_f(ss + EPS);
#pragma unroll
                for (int j = 0; j < 8; ++j) o[j] *= sc;
                u32x4 pb; pb.x = pk2(o[0], o[1]); pb.y = pk2(o[2], o[3]); pb.z = pk2(o[4], o[5]); pb.w = pk2(o[6], o[7]);
                if (which == 0) {
                    *(lu32x4*)(QB + c * BS + d0) = pb;
                    const float eg = sEG[c]; u32x4 qd; qd.x = pk2(o[0] * eg, o[1] * eg); qd.y = pk2(o[2] * eg, o[3] * eg); qd.z = pk2(o[4] * eg, o[5] * eg); qd.w = pk2(o[6] * eg, o[7] * eg);
                    *(gu32x4*)(rec + CB_QD + (size_t)(c * 128 + d0) * 2) = qd;
                } else {
                    *(lu32x4*)(KB + c * BS + d0) = pb;
                    *(lf32x4*)(KF + c * FS + d0) = (f32x4){o[0], o[1], o[2], o[3]}; *(lf32x4*)(KF + c * FS + d0 + 4) = (f32x4){o[4], o[5], o[6], o[7]};
                }
            }
        }
    }
    SYNC();
    {
        const int type = w >> 2, ct = w & 3, r = lane & 15, kg = lane >> 4; const lbf16* As = type == 0 ? KB : QB; gbf16* pm = (gbf16*)(rec + CB_PM);
        bf16x8 af[4];
#pragma unroll
        for (int s = 0; s < 4; ++s) af[s] = *(const lbf16x8*)(As + (ct * 16 + r) * BS + 32 * s + 8 * kg);
        for (int mt = 0; mt < 4; ++mt) {
            f32x4 acc = (f32x4){0.f, 0.f, 0.f, 0.f};
            if (mt <= ct) {
                bf16x8 bq[4];
#pragma unroll
                for (int s = 0; s < 4; ++s) bq[s] = *(const lbf16x8*)(KB + (mt * 16 + r) * BS + 32 * s + 8 * kg);
#pragma unroll
                for (int s = 0; s < 4; ++s) acc = mfma16(af[s], bq[s], acc);
            }
            const int mi = mt * 16 + r;
#pragma unroll
            for (int j = 0; j < 4; ++j) { const int ci = ct * 16 + 4 * kg + j; const float dec = (mi <= ci) ? EXPF(sG[ci] - sG[mi]) : 0.f;
                if (type == 0) AM[ci * AS + mi] = (mi < ci) ? -(sBeta[ci] * dec * acc[j]) : 0.f;
                else pm[ci * 64 + mi] = (bf16)bf1(acc[j] * dec); }
        }
        if (type == 0) {
            WAVE_FENCE();
            lf32* Nd = AM + (ct * 16) * AS + ct * 16;
            float x[16];
#pragma unroll
            for (int i = 0; i < 16; ++i) x[i] = (i == r) ? 1.f : 0.f;
#pragma unroll
            for (int i = 1; i < 16; ++i) {
                float s0 = x[i], s1 = 0.f;
#pragma unroll
                for (int q = 0; q < (i + 3) / 4; ++q) { const f32x4 a = *(const lf32x4*)(Nd + i * AS + 4 * q);
#pragma unroll
                    for (int e = 0; e < 4; ++e) if (4 * q + e < i) { if (e & 1) s1 += a[e] * x[4 * q + e]; else s0 += a[e] * x[4 * q + e]; } }
                x[i] = s0 + s1;
            }
            WAVE_FENCE();
#pragma unroll
            for (int i = 0; i < 16; ++i) if ((i >> 2) == kg) Nd[i * AS + r] = x[i];
        }
    }
    SYNC();
#ifndef HOSTSIM
    if (itn >= 0 && w < 7) {
        const int row0n = (itn >> 8) * T + (itn & 31) * CH, hn = (itn >> 5) & 7;
        const gu8* gb = w < 6 ? (const gu8*)(p.PROJ + (size_t)row0n * NPJ + PC_QKV + (w >> 1) * 1024 + hn * 128) : (const gu8*)(p.AB + (size_t)row0n * 16);
        const unsigned vo = w < 6 ? (unsigned)((32 * (w & 1) + (lane >> 1)) * (NPJ * 2) + 128 * (lane & 1)) : (unsigned)(lane * 64);
        unsigned keep; asm volatile("s_mov_b32 %0, m0\n\ts_mov_b32 m0, %2\n\ts_nop 0\n\tglobal_load_lds_dwordx4 %1, %3\n\ts_mov_b32 m0, %0" : "=&s"(keep) : "v"(vo), "s"((unsigned)(size_t)(lds + L1_QB) + 1024u * (unsigned)w), "s"(gb) : "memory");
    }
#endif
    {
        const int kk_ = tid >> 2, c0 = 16 * (tid & 3); unsigned o[8];
#pragma unroll
        for (int i = 0; i < 8; ++i) o[i] = pk2(KF[(c0 + 2 * i) * FS + kk_] * sEGE[c0 + 2 * i], KF[(c0 + 2 * i + 1) * FS + kk_] * sEGE[c0 + 2 * i + 1]);
        gu32x4* dst = (gu32x4*)(rec + CB_KET + (size_t)(kk_ * 64 + c0) * 2);
        dst[0] = (u32x4){o[0], o[1], o[2], o[3]}; dst[1] = (u32x4){o[4], o[5], o[6], o[7]};
    }
    {
        const int r = lane & 15, g = lane >> 4; const bool isv = w < 4;
        bf16x4 Mf[4][4];
#pragma unroll
        for (int I = 0; I < 4; ++I)
#pragma unroll
            for (int J = 0; J <= I; ++J) { const f32x4 m = *(const lf32x4*)(AM + (16 * I + r) * AS + 16 * J + 4 * g); const u32x2 t = {pk2(m[0], m[1]), pk2(m[2], m[3])}; Mf[I][J] = __builtin_bit_cast(bf16x4, t); }
        f32x4 acc[2][4]; f32x4 sol[2][4]; bf16x4 solb[2][4];
#pragma unroll
        for (int I = 0; I < 4; ++I) {
            const f32x4 be = *(const lf32x4*)(sBeta + 16 * I + 4 * g), eg = *(const lf32x4*)(sEG + 16 * I + 4 * g);
#pragma unroll
            for (int ctl = 0; ctl < 2; ++ctl) {
                const lf32* src = isv ? VF + (32 * w + 16 * ctl + r) : KF + (32 * w + 16 * ctl + r - 128);
#pragma unroll
                for (int rr = 0; rr < 4; ++rr) acc[ctl][I][rr] = (isv ? be[rr] : be[rr] * eg[rr]) * src[(16 * I + 4 * g + rr) * FS];
            }
        }
#pragma unroll
        for (int I = 0; I < 4; ++I) {
#pragma unroll
            for (int J = 0; J < I; ++J)
#pragma unroll
                for (int ctl = 0; ctl < 2; ++ctl) acc[ctl][I] = mfma16k(Mf[I][J], solb[ctl][J], acc[ctl][I]);
#pragma unroll
            for (int ctl = 0; ctl < 2; ++ctl) { const u32x2 t = {pk2(acc[ctl][I][0], acc[ctl][I][1]), pk2(acc[ctl][I][2], acc[ctl][I][3])};
                sol[ctl][I] = mfma16k(Mf[I][I], __builtin_bit_cast(bf16x4, t), (f32x4){0.f, 0.f, 0.f, 0.f});
                const u32x2 t2 = {pk2(sol[ctl][I][0], sol[ctl][I][1]), pk2(sol[ctl][I][2], sol[ctl][I][3])}; solb[ctl][I] = __builtin_bit_cast(bf16x4, t2); }
        }
#pragma unroll
        for (int ctl = 0; ctl < 2; ++ctl) {
            const int col = 32 * w + 16 * ctl + r;
            if (isv) {
#pragma unroll
                for (int I = 0; I < 4; ++I) { u32x2 ub; ub.x = pk2(sol[ctl][I][0], sol[ctl][I][1]); ub.y = pk2(sol[ctl][I][2], sol[ctl][I][3]); *(gu32x2*)(rec + CB_UBT + ((size_t)col * 64 + 16 * I + 4 * g) * 2) = ub; }
            } else {
#pragma unroll
                for (int I = 0; I < 4; ++I)
#pragma unroll
                    for (int rr = 0; rr < 4; ++rr) WST[(16 * I + 4 * g + rr) * 128 + col - 128] = (bf16)bf1(-sol[ctl][I][rr]);
            }
        }
    }
    SYNC();
    {
        const lu32x4* s = (const lu32x4*)WST; gu32x4* dst = (gu32x4*)(rec + CB_WMN);
        dst[tid] = s[tid]; dst[tid + 512] = s[tid + 512];
        if (tid == 0) *(gf32*)(rec + CB_GE) = EXPF(sG[63]);
    }
    SYNC();
}

constexpr int L2_WM = 0, L2_QD = 17408, L2_KET = 34816, L2_PM = 53248, L2_OPS = 62464, L2_SBX = 2 * L2_OPS, L2_UBX = L2_SBX + 8192, L2_OT = L2_UBX + 4096, L2_PS = L2_OT + 5120;
constexpr int KS2 = 72, OTS = 40;
constexpr int L2_TOUCH = L2_PS + 512;
static_assert(L2_TOUCH + 2048 <= LDS_BYTES - 256, "scan LDS map");
DI void mx2_scan_item(const P& p, int l, int item, lu8* lds) {
    const int tid = TID, lane = tid & 63, w = WAVE_OF(tid), r = lane & 15, kg = lane >> 4;
    const int bh = item >> 2, vq = item & 3, b = bh >> 3, h = bh & 7, vt = w & 1, j = w >> 1, vl = 16 * vt + r, v = 32 * vq + vl;
    lu32x4* SBX = (lu32x4*)(lds + L2_SBX); lu8* UBX = lds + L2_UBX; lbf16* OT = (lbf16*)(lds + L2_OT); lf32* PS = (lf32*)(lds + L2_PS);
    const gu8* rec0 = p.MXB + (size_t)(bh * NCH) * CHB;
    const int q0 = tid, q1 = tid + 512;
    gbf16* og = p.ORAW + (size_t)(b * T) * DC + 128 * h + 32 * vq;
    gf32* pg = p.PSS + ((size_t)(b * T) * H + h) * 4 + vq;
    f32x4 ST2[2];
    ST2[0] = (f32x4){0.f, 0.f, 0.f, 0.f}; ST2[1] = ST2[0];
    u32x4 pw0, pw1, pq0, pq1, pk0, pk1, pp; u32x2 Un; float gen;
#define MX2_LOAD(n_) do { const gu8* _r = rec0 + (size_t)(n_) * CHB; \
        pw0 = *(const gu32x4*)(_r + CB_WMN + q0 * 16); pw1 = *(const gu32x4*)(_r + CB_WMN + q1 * 16); \
        pq0 = *(const gu32x4*)(_r + CB_QD + q0 * 16); pq1 = *(const gu32x4*)(_r + CB_QD + q1 * 16); \
        pk0 = *(const gu32x4*)(_r + CB_KET + q0 * 16); pk1 = *(const gu32x4*)(_r + CB_KET + q1 * 16); \
        pp = *(const gu32x4*)(_r + CB_PM + q0 * 16); \
        Un = *(const gu32x2*)(_r + CB_UBT + (size_t)(v * 64 + 16 * j + 4 * kg) * 2); \
        gen = *(const gf32*)(_r + CB_GE); } while (0)
#define MX2_STORE(set_) do { lu8* _b = lds + (set_) * L2_OPS; lbf16* _wm = (lbf16*)(_b + L2_WM); lbf16* _qd = (lbf16*)(_b + L2_QD); lbf16* _ke = (lbf16*)(_b + L2_KET); lbf16* _pm = (lbf16*)(_b + L2_PM); \
        *(lu32x4*)(_wm + (q0 >> 4) * BS + (q0 & 15) * 8) = pw0; *(lu32x4*)(_wm + (q1 >> 4) * BS + (q1 & 15) * 8) = pw1; \
        *(lu32x4*)(_qd + (q0 >> 4) * BS + (q0 & 15) * 8) = pq0; *(lu32x4*)(_qd + (q1 >> 4) * BS + (q1 & 15) * 8) = pq1; \
        *(lu32x4*)(_ke + (q0 >> 3) * KS2 + (q0 & 7) * 8) = pk0; *(lu32x4*)(_ke + (q1 >> 3) * KS2 + (q1 & 7) * 8) = pk1; \
        *(lu32x4*)(_pm + (q0 >> 3) * KS2 + (q0 & 7) * 8) = pp; } while (0)
    MX2_LOAD(0); MX2_STORE(0);
    SBX[(vt * 4 + j) * 64 + lane] = (u32x4){0u, 0u, 0u, 0u};
#define MX2_UEXP() (f32x4){bflo(Un.x), bfhi(Un.x), bflo(Un.y), bfhi(Un.y)}
    f32x4 U = MX2_UEXP(); float ge = gen;
    if (NCH > 1) MX2_LOAD(1);
    LDS_BARRIER();
    for (int n = 0; n < NCH; ++n) {
#ifndef HOSTSIM
        if (n + 3 < NCH) {
            const int L = w * 64 + lane; const gu8* r3 = rec0 + (size_t)(n + 3) * CHB;
            const unsigned vo = L < 448 ? (unsigned)(CB_WMN + L * 128) : (unsigned)(CB_UBT + (32 * vq + ((L - 448) & 31)) * 128);
            unsigned keep; asm volatile("s_mov_b32 %0, m0\n\ts_mov_b32 m0, %2\n\ts_nop 0\n\tglobal_load_lds_dword %1, %3\n\ts_mov_b32 m0, %0" : "=&s"(keep) : "v"(vo), "s"((unsigned)(size_t)(lds + L2_TOUCH) + 256u * (unsigned)w), "s"(r3) : "memory"); }
#endif
        const lu8* ob = lds + (n & 1) * L2_OPS; const lbf16* WM = (const lbf16*)(ob + L2_WM); const lbf16* QD = (const lbf16*)(ob + L2_QD); const lbf16* KET = (const lbf16*)(ob + L2_KET); const lbf16* PM = (const lbf16*)(ob + L2_PM);
        bf16x8 SB[4], Af[4], Aq[4];
#pragma unroll
        for (int s = 0; s < 4; ++s) { SB[s] = __builtin_bit_cast(bf16x8, SBX[(vt * 4 + s) * 64 + lane]);
            Af[s] = frag2(WM, (16 * j + r) * BS + 32 * s + 4 * kg, (16 * j + r) * BS + 32 * s + 16 + 4 * kg);
            Aq[s] = frag2(QD, (16 * j + r) * BS + 32 * s + 4 * kg, (16 * j + r) * BS + 32 * s + 16 + 4 * kg); }
        f32x4 O = (f32x4){0.f, 0.f, 0.f, 0.f};
#pragma unroll
        for (int s = 0; s < 4; ++s) { U = mfma16(Af[s], SB[s], U); O = mfma16(Aq[s], SB[s], O); }
        { u32x2 uh; uh.x = pk2(U[0], U[1]); uh.y = pk2(U[2], U[3]); *(lu32x2*)(UBX + ((vt * 2 + (j >> 1)) * 64 + lane) * 16 + (j & 1) * 8) = uh; }
        LDS_BARRIER();
        bf16x8 UB[2], Ap[2], Ak[4];
#pragma unroll
        for (int s = 0; s < 2; ++s) { UB[s] = __builtin_bit_cast(bf16x8, *(const lu32x4*)(UBX + ((vt * 2 + s) * 64 + lane) * 16));
            Ap[s] = frag2(PM, (16 * j + r) * KS2 + 32 * s + 4 * kg, (16 * j + r) * KS2 + 32 * s + 16 + 4 * kg);
            Ak[s] = frag2(KET, (16 * (2 * j) + r) * KS2 + 32 * s + 4 * kg, (16 * (2 * j) + r) * KS2 + 32 * s + 16 + 4 * kg);
            Ak[2 + s] = frag2(KET, (16 * (2 * j + 1) + r) * KS2 + 32 * s + 4 * kg, (16 * (2 * j + 1) + r) * KS2 + 32 * s + 16 + 4 * kg); }
        ST2[0] = ST2[0] * ge; ST2[1] = ST2[1] * ge;
#pragma unroll
        for (int s = 0; s < 2; ++s) { ST2[0] = mfma16(Ak[s], UB[s], ST2[0]); ST2[1] = mfma16(Ak[2 + s], UB[s], ST2[1]); O = mfma16(Ap[s], UB[s], O); }
        SBX[(vt * 4 + j) * 64 + lane] = __builtin_bit_cast(u32x4, pack8(ST2[0], ST2[1]));
#pragma unroll
        for (int jj = 0; jj < 4; ++jj) { const int c = 16 * j + 4 * kg + jj; OT[c * OTS + vl] = (bf16)bf1(O[jj]); const float q = sum16_f(O[jj] * O[jj]); if (r == 0) PS[c * 2 + vt] = q; }
        if (n + 1 < NCH) { MX2_STORE((n + 1) & 1); U = MX2_UEXP(); ge = gen; }
        if (n + 2 < NCH) MX2_LOAD(n + 2);
        LDS_BARRIER();
        if (tid < 256) *(gu32x4*)(og + (size_t)(n * CH + (tid >> 2)) * DC + (tid & 3) * 8) = *(const lu32x4*)(OT + (tid >> 2) * OTS + (tid & 3) * 8);
        else if (tid < 320) { const int c = tid - 256; pg[(size_t)(n * CH + c) * 32] = PS[c * 2] + PS[c * 2 + 1]; }
    }
#undef MX2_LOAD
#undef MX2_UEXP
#undef MX2_STORE
    gf32* dst = p.out + O_DL_P + ((size_t)((l * NB + b) * H + h) * DV + v) * DK;
    *(gf32x4*)(dst + 16 * (2 * j) + 4 * kg) = ST2[0]; *(gf32x4*)(dst + 16 * (2 * j + 1) + 4 * kg) = ST2[1];
    SYNC();
}
DI void mx3_finish(const P& p, int l) {
    const int tid = TID, lane = tid & 63, gw = BID * NWAVES + WAVE_OF(tid), ngw = GRID * NWAVES;
    const int c0 = 16 * lane, hh = lane >> 3;
    float wv[16];
#pragma unroll
    for (int q = 0; q < 4; ++q) { const f32x4 a = *(const gf32x4*)(p.dn_norm_w + l * DV + (c0 & 127) + 4 * q); wv[4 * q] = a[0]; wv[4 * q + 1] = a[1]; wv[4 * q + 2] = a[2]; wv[4 * q + 3] = a[3]; }
    for (int m = gw; m < MP; m += ngw) {
        const u32x4 o0 = *(const gu32x4*)(p.ORAW + (size_t)m * DC + c0), o1 = *(const gu32x4*)(p.ORAW + (size_t)m * DC + c0 + 8);
        const u32x4 z0 = *(const gu32x4*)(p.PROJ + (size_t)m * NPJ + PC_Z + c0), z1 = *(const gu32x4*)(p.PROJ + (size_t)m * NPJ + PC_Z + c0 + 8);
        const f32x4 ps = *(const gf32x4*)(p.PSS + ((size_t)m * H + hh) * 4);
        const float rs = rsqrt_f(((ps[0] + ps[1]) + (ps[2] + ps[3])) * (1.0f / DV) + EPS);
        u32x4 r0, r1;
#pragma unroll
        for (int e = 0; e < 4; ++e) {
            r0[e] = pk2(bflo(o0[e]) * rs * wv[2 * e] * silu_f(bflo(z0[e])), bfhi(o0[e]) * rs * wv[2 * e + 1] * silu_f(bfhi(z0[e])));
            r1[e] = pk2(bflo(o1[e]) * rs * wv[8 + 2 * e] * silu_f(bflo(z1[e])), bfhi(o1[e]) * rs * wv[8 + 2 * e + 1] * silu_f(bfhi(z1[e]))); }
        *(gu32x4*)(p.MIX + (size_t)m * D + DC + c0) = r0; *(gu32x4*)(p.MIX + (size_t)m * D + DC + c0 + 8) = r1;
    }
}
constexpr int SMP_LDS = 16640;
DI void mx2_sample_item(const P& p, int l, int it, lu8* lds, int wave, int lane) {
    const int sb = it >> 3, h = it & 7, m0 = MP + 4 * sb;
    lf32* QKV = (lf32*)(lds + wave * SMP_LDS);
    lf32* OO = QKV + 1536;
    lf32* sEG = OO + 512, *sBeta = sEG + 4;
    const gf32* cw = p.conv_qkv_w + (size_t)l * 4 * 3072;
#pragma unroll
    for (int i = 0; i < 6; ++i) {
        const int j = lane + 64 * i, which = j >> 7, d = j & 127, col = which * 1024 + h * 128 + d;
        const float w0 = cw[col], w1 = cw[3072 + col], w2 = cw[2 * 3072 + col], w3 = cw[3 * 3072 + col];
        const gf32* st = p.st_conv_qkv + ((size_t)(l * SB + sb) * 3) * 3072 + col;
        float x3 = st[0], x2 = st[3072], x1 = st[2 * 3072];
#pragma unroll
        for (int t = 0; t < 4; ++t) { const float x0 = bf2f(p.PROJ[(size_t)(m0 + t) * NPJ + PC_QKV + col]); QKV[(which * 4 + t) * 128 + d] = silu_f(w0 * x3 + w1 * x2 + w2 * x1 + w3 * x0); x3 = x2; x2 = x1; x1 = x0; }
    }
    if (lane < 4) { const float a = p.AB[(size_t)(m0 + lane) * 16 + h], bb = p.AB[(size_t)(m0 + lane) * 16 + 8 + h];
        sEG[lane] = EXPF(-EXPF(p.a_log[l * H + h]) * softplus_f(a + p.dt_bias[l * H + h])); sBeta[lane] = sigmoid_f(bb); }
    WAVE_FENCE();
#pragma unroll
    for (int rw = 0; rw < 8; ++rw) {
        lf32* row = QKV + rw * 128; const float a = row[lane], c = row[lane + 64]; const float ss = wave_sum(a * a + c * c);
        const float sc = (rw < 4 ? 0.08838834764831845f : 1.0f) * rsqrt_f(ss + EPS); row[lane] = a * sc; row[lane + 64] = c * sc;
    }
    WAVE_FENCE();
    const int vr = lane >> 2, pp = lane & 3;
    const gf32* sin = p.st_delta + ((size_t)((l * SB + sb) * H + h) * DV + vr) * DK + 4 * pp;
    gf32* sout = p.out + O_DL_S + ((size_t)((l * SB + sb) * H + h) * DV + vr) * DK + 4 * pp;
    f32x4 Sn[8];
#pragma unroll
    for (int i = 0; i < 8; ++i) Sn[i] = *(const gf32x4*)(sin + 16 * i);
    for (int ps = 0; ps < 8; ++ps) {
        f32x4 S[8];
#pragma unroll
        for (int i = 0; i < 8; ++i) S[i] = Sn[i];
        if (ps + 1 < 8) {
#pragma unroll
            for (int i = 0; i < 8; ++i) Sn[i] = *(const gf32x4*)(sin + (size_t)(ps + 1) * 16 * DK + 16 * i);
        }
        const int vv = 16 * ps + vr;
#pragma unroll
        for (int t = 0; t < 4; ++t) {
            const float eg = sEG[t], be = sBeta[t]; const lf32* kt = QKV + (4 + t) * 128 + 4 * pp; const lf32* qt = QKV + t * 128 + 4 * pp; float rr = 0.f;
            f32x4 kv[8];
#pragma unroll
            for (int i = 0; i < 8; ++i) { kv[i] = *(const lf32x4*)(kt + 16 * i); S[i] = S[i] * eg; rr += (S[i][0] * kv[i][0] + S[i][1] * kv[i][1]) + (S[i][2] * kv[i][2] + S[i][3] * kv[i][3]); }
            rr = sum4_f(rr);
            const float dl = be * (QKV[(8 + t) * 128 + vv] - rr); float oo = 0.f;
#pragma unroll
            for (int i = 0; i < 8; ++i) { const f32x4 qv = *(const lf32x4*)(qt + 16 * i); S[i] = S[i] + kv[i] * dl; oo += (S[i][0] * qv[0] + S[i][1] * qv[1]) + (S[i][2] * qv[2] + S[i][3] * qv[3]); }
            oo = sum4_f(oo);
            if (pp == 0) OO[t * 128 + vv] = oo;
        }
#pragma unroll
        for (int i = 0; i < 8; ++i) *(gf32x4*)(sout + (size_t)ps * 16 * DK + 16 * i) = S[i];
    }
    WAVE_FENCE();
#pragma unroll
    for (int t = 0; t < 4; ++t) {
        const float a = OO[t * 128 + lane], c = OO[t * 128 + lane + 64]; const float ss = wave_sum(a * a + c * c); const float rs = rsqrt_f(ss * (1.0f / DV) + EPS);
        const size_t m = (size_t)(m0 + t);
        const float z0 = bf2f(p.PROJ[m * NPJ + PC_Z + 128 * h + lane]), z1 = bf2f(p.PROJ[m * NPJ + PC_Z + 128 * h + lane + 64]);
        p.MIX[m * D + DC + 128 * h + lane] = (bf16)bf1(a * rs * p.dn_norm_w[l * DV + lane] * silu_f(z0));
        p.MIX[m * D + DC + 128 * h + lane + 64] = (bf16)bf1(c * rs * p.dn_norm_w[l * DV + lane + 64] * silu_f(z1));
    }
    WAVE_FENCE();
}
#ifndef REPK
#define REPK -1
#endif
#define SUBREP(bit) (((REPK >= 0) && ((REPK >> (bit)) & 1)) ? 2 : 1)
DI void mx2_phase(const P& p, int l, lu8* lds) {
    const int G = GRID, bid = BID;
    constexpr int NSC = NB * H * 4;
    if (G > NSC) {
        if (bid < NSC) { const int item = ((bid & 7) + 8 * (bid >> 5)) * 4 + ((bid >> 3) & 3);
            for (int rp = 0; rp < SUBREP(10); ++rp) mx2_scan_item(p, l, item, lds); }
        else { const int tid = TID, lane = tid & 63, wave = WAVE_OF(tid), nwg = G - NSC, wi = wave * nwg + (bid - NSC), nw = nwg * NWAVES;
            for (int rp = 0; rp < SUBREP(11); ++rp) for (int it = wi; it < SB * H; it += nw) mx2_sample_item(p, l, it, lds, wave, lane);
            if (CONV_IN_MX2 && l + 1 < DEPTH) convert_layer(p, l + 1, lds, wi, nw, wave, lane, 0, CONV_SPLIT); }
    } else {
        for (int it = bid; it < NSC; it += G) mx2_scan_item(p, l, it, lds);
        const int tid = TID, lane = tid & 63, wave = WAVE_OF(tid), wi = bid * NWAVES + wave, nw = G * NWAVES;
        for (int it = wi; it < SB * H; it += nw) mx2_sample_item(p, l, it, lds, wave, lane);
    }
}
DI void mx3_phase(const P& p, int l, lu8* lds) {
    mx3_finish(p, l);
    if (CONV_IN_MX2 && l + 1 < DEPTH) { const int tid = TID, lane = tid & 63, wave = WAVE_OF(tid);
        for (int rp = 0; rp < SUBREP(12); ++rp) convert_layer(p, l + 1, lds, BID * NWAVES + wave, GRID * NWAVES, wave, lane, (GRID > NB * H * 4) ? CONV_SPLIT : 0, IT_LAYER); }
}
#ifndef HOSTSIM
constexpr int NPL = 7, N_PHASES = 2 + NPL * DEPTH;
constexpr int CW_BAR = 4096;
constexpr int MISC_OFF = LDS_BYTES - 64, PRM_OFF = LDS_BYTES - 256;
struct Args { const float* in[18]; float* out; unsigned char* ws; int ph_lo, ph_hi; };
__global__ void __launch_bounds__(NWAVES * 64, 2) fwd(Args args) {
    extern __shared__ __attribute__((aligned(16))) unsigned char lds[];
    const int tid = threadIdx.x;
    const int G = gridDim.x, bid = blockIdx.x;
    LAS unsigned char* ldsl = (LAS unsigned char*)lds;
    volatile LAS unsigned* MISC = (volatile LAS unsigned*)(ldsl + MISC_OFF);
    if (tid < 16) MISC[tid] = 0u;
    if (tid < 20) { const unsigned long long v = tid < 18 ? (unsigned long long)args.in[tid] : (tid == 18 ? (unsigned long long)args.out : (unsigned long long)args.ws);
        ((LAS unsigned long long*)(ldsl + PRM_OFF))[tid] = v; }
    __syncthreads();
    const int lo = args.ph_lo, hi = args.ph_hi;
    unsigned* ctl = (unsigned*)(args.ws + WS_CTL);
    XcdBarrier bar; bar.bar = ctl + CW_BAR; bar.x = 0; bar.st = nullptr;
    if (hi - lo > 1) bar = xcd_barrier_post(ctl + CW_BAR, MISC + 8);
#ifndef REPK
#define REPK -1
#endif
#define NREP(kind) (((REPK >= 0) && ((REPK >> (kind)) & 1)) ? 2 : 1)
#ifndef PHMASK
#define PHMASK 0x1ff
#endif
#define EN(kind) ((PHMASK >> (kind)) & 1)
#define IN(k) (lo <= (k) && (k) < hi)
#define LOADP() P p; { int _o = PRM_OFF; asm volatile("" : "+v"(_o)); const LAS unsigned long long* _q = (const LAS unsigned long long*)(ldsl + _o); \
        unsigned long long _v[20]; _Pragma("unroll") for (int _i = 0; _i < 20; ++_i) { const unsigned long long _t = _q[_i]; _v[_i] = ((unsigned long long)(unsigned)__builtin_amdgcn_readfirstlane((int)(_t >> 32)) << 32) | (unsigned)__builtin_amdgcn_readfirstlane((int)_t); } \
        p.x_prompt = (const gf32*)_v[0]; p.x_sample = (const gf32*)_v[1]; p.st_conv_a = (const gf32*)_v[2]; p.st_conv_qkv = (const gf32*)_v[3]; p.st_delta = (const gf32*)_v[4]; p.norm_mix_w = (const gf32*)_v[5]; p.w_in = (const gf32*)_v[6]; \
        p.conv_a_w = (const gf32*)_v[7]; p.conv_a_norm_w = (const gf32*)_v[8]; p.conv_qkv_w = (const gf32*)_v[9]; p.a_log = (const gf32*)_v[10]; p.dt_bias = (const gf32*)_v[11]; p.dn_norm_w = (const gf32*)_v[12]; p.w_out = (const gf32*)_v[13]; \
        p.norm_ffn_w = (const gf32*)_v[14]; p.w_up = (const gf32*)_v[15]; p.w_down = (const gf32*)_v[16]; p.final_norm_w = (const gf32*)_v[17]; p.out = (gf32*)_v[18]; p.ws = (gu8*)_v[19]; \
        p.X = (gf32*)(p.ws + WS_X); p.XB = (gbf16*)(p.ws + WS_XB); p.SSQ = (gf32*)(p.ws + WS_SSQ); p.PROJ = (gbf16*)(p.ws + WS_PROJ); p.AB = (gf32*)(p.ws + WS_AB); \
        p.MIX = (gbf16*)(p.ws + WS_MIX); p.UP = (gbf16*)(p.ws + WS_UP); p.MXB = p.ws + WS_MXB; p.ORAW = (gbf16*)(p.ws + WS_ORAW); p.PSS = (gf32*)(p.ws + WS_PSS); }
#define SEAM(k) do { if (IN(k) && IN((k) + 1)) { xcd_barrier(bar); if (REPK >= 0 && ((REPK >> 9) & 1)) xcd_barrier(bar); } } while (0)

    if (EN(0) && IN(0)) _Pragma("nounroll") for (int rep = 0; rep < NREP(0); ++rep) { LOADP(); p0_prologue(p, ldsl); if (rep == NREP(0) - 1) SEAM(0); }
    for (int l = 0; l < DEPTH; ++l) {
        const int pb = 1 + NPL * l;
        if (EN(2) && IN(pb + 0)) _Pragma("nounroll") for (int rep = 0; rep < NREP(2); ++rep) {
            LOADP(); const gu8* wl = p.ws + WS_W + (size_t)l * WL_BYTES; pg8::Gemm g{(const bf16*)p.XB, (const bf16*)(p.XB + (size_t)MP * D), (const bf16*)(wl + WL_IN), M, NPAD, D}; pg8::StaticOrder S; S.init(M, NPAD, G, bid);
            pg8::EpiProj E{p.PROJ, p.AB, p.SSQ + (size_t)(2 * l) * SSQ_ARR};
            pg8::gemm_phase<pg8::EpiProj, pg8::StaticOrder, true, true, false>(ldsl, g, S, E);
            if (rep == NREP(2) - 1) SEAM(pb + 0);
        }
        if (EN(3) && IN(pb + 1)) _Pragma("nounroll") for (int rep = 0; rep < NREP(3); ++rep) {
            LOADP();
            for (int rp = 0; rp < SUBREP(13); ++rp) for (int it = bid; it < NB * H * NCH; it += G) mx1_chunk_item(p, l, it, it + G < NB * H * NCH ? it + G : -1, ldsl);
            for (int rp = 0; rp < SUBREP(14); ++rp) mx1_conva_phase(p, l);
            for (int rp = 0; rp < SUBREP(15); ++rp) mx1_convstate_copy(p, l);
            if (rep == NREP(3) - 1) SEAM(pb + 1);
        }
        if (EN(4) && IN(pb + 2)) _Pragma("nounroll") for (int rep = 0; rep < NREP(4); ++rep) {
            LOADP();
            mx2_phase(p, l, ldsl);
            if (rep == NREP(4) - 1) SEAM(pb + 2);
        }
        if (EN(1) && IN(pb + 3)) _Pragma("nounroll") for (int rep = 0; rep < NREP(1); ++rep) {
            LOADP();
            mx3_phase(p, l, ldsl);
            if (rep == NREP(1) - 1) SEAM(pb + 3);
        }
        if (EN(5) && IN(pb + 4)) _Pragma("nounroll") for (int rep = 0; rep < NREP(5); ++rep) {
            LOADP(); const gu8* wl = p.ws + WS_W + (size_t)l * WL_BYTES; pg8::Gemm g{(const bf16*)p.MIX, (const bf16*)(p.MIX + (size_t)MP * D), (const bf16*)(wl + WL_OUT), MP, D, D}; pg8::StaticOrder S; S.init(MP, D, G, bid);
            pg8::EpiRes E{p.XB, p.SSQ + (size_t)(2 * l + 1) * SSQ_ARR, D, rep == 0 ? 1.0f : (float)lo, (gf32*)nullptr};
            pg8::gemm_phase<pg8::EpiRes, pg8::StaticOrder, true, true>(ldsl, g, S, E);
            if (rep == NREP(5) - 1) SEAM(pb + 4);
        }
        if (EN(6) && IN(pb + 5)) _Pragma("nounroll") for (int rep = 0; rep < NREP(6); ++rep) {
            LOADP(); const gu8* wl = p.ws + WS_W + (size_t)l * WL_BYTES; pg8::Gemm g{(const bf16*)p.XB, (const bf16*)(p.XB + (size_t)MP * D), (const bf16*)(wl + WL_UP), MP, DFF, D}; pg8::StaticOrder S; S.init(MP, DFF, G, bid);
            pg8::EpiUp E{p.UP, DFF, p.SSQ + (size_t)(2 * l + 1) * SSQ_ARR};
#if defined(PROBE_NOXR)
            if (rep == 0) pg8::gemm_phase<pg8::EpiUp, pg8::StaticOrder, true, true>(ldsl, g, S, E); else pg8::gemm_phase<pg8::EpiUp, pg8::StaticOrder, true, true, false>(ldsl, g, S, E);
#else
            pg8::gemm_phase<pg8::EpiUp, pg8::StaticOrder, true, true>(ldsl, g, S, E);
#endif
            if (rep == NREP(6) - 1) SEAM(pb + 5);
        }
        if (EN(7) && IN(pb + 6)) _Pragma("nounroll") for (int rep = 0; rep < NREP(7); ++rep) {
            LOADP(); const gu8* wl = p.ws + WS_W + (size_t)l * WL_BYTES; pg8::Gemm g{(const bf16*)p.UP, (const bf16*)(p.UP + (size_t)MP * DFF), (const bf16*)(wl + WL_DOWN), MP, D, DFF}; pg8::StaticOrder S; S.init(MP, D, G, bid);
            pg8::EpiRes E{p.XB, p.SSQ + (size_t)(2 * l + 2) * SSQ_ARR, D, rep == 0 ? 1.0f : (float)lo, (gf32*)nullptr};
            pg8::gemm_phase<pg8::EpiRes, pg8::StaticOrder, true, true>(ldsl, g, S, E);
            if (rep == NREP(7) - 1) SEAM(pb + 6);
        }
    }
    if (EN(8) && IN(N_PHASES - 1)) _Pragma("nounroll") for (int rep = 0; rep < NREP(8); ++rep) { LOADP(); fin_phase(p); }
#undef IN
#undef SEAM
}

#ifndef MK_ONE_LAUNCH
#define MK_ONE_LAUNCH 1
#endif
extern "C" void kernel_launch(void* const* d_in, const int* in_sizes, int n_in, void* d_out, int out_size, void* d_ws, size_t ws_size, hipStream_t stream) {
    static int grid = 0;
    if (grid == 0) {
        if (n_in != 18 || (size_t)out_size != O_END || ws_size < WS_END) { fprintf(stderr, "kernel_launch: unexpected shapes (n_in %d out %d ws %zu)\n", n_in, out_size, ws_size); grid = -1; return; }
        int dev = 0, cus = 0, per_cu = 0;
        if (hipGetDevice(&dev) != hipSuccess || hipDeviceGetAttribute(&cus, hipDeviceAttributeMultiprocessorCount, dev) != hipSuccess) { grid = -1; return; }
        if (hipFuncSetAttribute((const void*)fwd, hipFuncAttributeMaxDynamicSharedMemorySize, LDS_BYTES) != hipSuccess) { fprintf(stderr, "kernel_launch: hipFuncSetAttribute failed\n"); grid = -1; return; }
        if (hipOccupancyMaxActiveBlocksPerMultiprocessor(&per_cu, (const void*)fwd, NWAVES * 64, LDS_BYTES) != hipSuccess || per_cu < 1) { fprintf(stderr, "kernel_launch: occupancy query says %d\n", per_cu); }
        (void)hipGetLastError();
        grid = cus;
    }
    if (grid < 0) return;
    if (hipMemsetAsync((char*)d_ws + WS_CTL, 0, CTL_BYTES, stream) != hipSuccess) return;
    Args a{};
    for (int i = 0; i < 18; ++i) a.in[i] = (const float*)d_in[i];
    a.out = (float*)d_out; a.ws = (unsigned char*)d_ws;
#if MK_ONE_LAUNCH
    a.ph_lo = 0; a.ph_hi = N_PHASES;
    hipLaunchKernelGGL(fwd, dim3(grid), dim3(NWAVES * 64), LDS_BYTES, stream, a);
#else
    for (int k = 0; k < N_PHASES; ++k) { a.ph_lo = k; a.ph_hi = k + 1; hipLaunchKernelGGL(fwd, dim3(grid), dim3(NWAVES * 64), LDS_BYTES, stream, a); }
#endif
}
#endif
```
